# Optimizing an MI355X kernel written in HIP

```python
import jax, jax.numpy as jnp
from jax import lax
import numpy as np

D_MODEL = 1024
BATCH = 4
SEQ = 8192
DEPTH = 2

N_EVEN = (DEPTH + 1) // 2
N_ODD = DEPTH // 2
EPS = 1e-6

GLA_HEADS = 4
GLA_DK = 64
GLA_DV = 128
GLA_RANK = 16
GLA_TAU = 16.0
GLA_CHUNK = 64
GLA_QK = GLA_HEADS * GLA_DK
GLA_V = GLA_HEADS * GLA_DV

SWA_HEADS = 8
SWA_KV_HEADS = 2
SWA_HEAD_DIM = 64
SWA_GROUP = SWA_HEADS // SWA_KV_HEADS
WINDOW = 128
SWA_BLOCK = 128
SWA_Q = SWA_HEADS * SWA_HEAD_DIM
SWA_KV = SWA_KV_HEADS * SWA_HEAD_DIM

N_BUCKETS = 32
MAX_DISTANCE = 128

IN_SPLITS = (GLA_QK, GLA_QK, GLA_V, GLA_V, GLA_RANK, SWA_Q, SWA_KV, SWA_KV)
IN_COLS = GLA_QK + GLA_QK + GLA_V + GLA_V + GLA_RANK + SWA_Q + SWA_KV + SWA_KV
MIX_OUT = GLA_V + SWA_Q

POOL_WINDOWS = (2, 4, 8, 16)
POOL_GROUP = D_MODEL // 4

D_FF = 4 * D_MODEL

kernel_name = "hybrid_gla_swa_pool_adaln"


def rms_norm(x, w):
    xf = x.astype(jnp.float32)
    y = xf * lax.rsqrt(jnp.mean(xf * xf, axis=-1, keepdims=True) + EPS)
    return (y * w.astype(jnp.float32)).astype(x.dtype)


def ada_modulation(c, w, b):
    mod = jax.nn.silu(c) @ w + b
    shift, scale, gate = jnp.split(mod, 3, axis=-1)
    return shift[:, None], scale[:, None], gate[:, None]


def t5_bucket(dist):
    max_exact = N_BUCKETS // 2
    d = np.maximum(dist, 1).astype(np.float64)
    large = max_exact + (np.log(d / max_exact) / np.log(MAX_DISTANCE / max_exact)
                         * (N_BUCKETS - max_exact)).astype(np.int32)
    large = np.minimum(large, N_BUCKETS - 1)
    return np.where(dist < max_exact, dist, large).astype(np.int32)


def gla_chunked(q, k, v, log_a):
    B, S, H, dk = q.shape
    dv = v.shape[-1]
    C = GLA_CHUNK
    nc = S // C
    f32 = jnp.float32
    qf = (q.astype(f32) * dk ** -0.5).reshape(B, nc, C, H, dk)
    kf = k.astype(f32).reshape(B, nc, C, H, dk)
    vf = v.astype(f32).reshape(B, nc, C, H, dv)
    b = jnp.cumsum(log_a.reshape(B, nc, C, H, dk), axis=2)
    b_last = b[:, :, -1]
    q_t = qf * jnp.exp(b)
    k_t = kf * jnp.exp(-b)
    k_end = kf * jnp.exp(b_last[:, :, None] - b)
    causal = jnp.tril(jnp.ones((C, C), dtype=bool))
    a = jnp.einsum('bnihd,bnjhd->bnhij', q_t, k_t)
    a = jnp.where(causal, a, 0.0)
    o_intra = jnp.einsum('bnhij,bnjhe->bnihe', a, vf)
    d_state = jnp.einsum('bnjhd,bnjhe->bnhde', k_end, vf)
    decay = jnp.exp(b_last)

    def step(s_prev, inp):
        ds, dec = inp
        return dec[..., None] * s_prev + ds, s_prev

    _, s_in = lax.scan(step, jnp.zeros((B, H, dk, dv), f32),
                       (jnp.moveaxis(d_state, 1, 0), jnp.moveaxis(decay, 1, 0)))
    s_in = jnp.moveaxis(s_in, 0, 1)
    o_inter = jnp.einsum('bnihd,bnhde->bnihe', q_t, s_in)
    return (o_intra + o_inter).reshape(B, S, H, dv)


def sliding_window_attention(q, k, v, rel_bias, sinks):
    B, S = q.shape[0], q.shape[1]
    nb = S // SWA_BLOCK
    L = SWA_BLOCK
    f32 = jnp.float32
    qb = q.reshape(B, nb, L, SWA_KV_HEADS, SWA_GROUP, SWA_HEAD_DIM)

    def band(t):
        tb = t.reshape(B, nb, L, SWA_KV_HEADS, SWA_HEAD_DIM)
        prev = jnp.pad(tb, ((0, 0), (1, 0), (0, 0), (0, 0), (0, 0)))[:, :-1]
        return jnp.concatenate([prev, tb], axis=2)

    kb, vb = band(k), band(v)
    s = jnp.einsum('bnqhgd,bnkhd->bnhgqk', qb, kb,
                   preferred_element_type=f32) * (SWA_HEAD_DIM ** -0.5)
    qi = np.arange(L)[:, None] + L
    kj = np.arange(2 * L)[None, :]
    dist = qi - kj
    valid = (dist >= 0) & (dist < WINDOW)
    bucket = t5_bucket(np.maximum(dist, 0))
    bias = jnp.transpose(rel_bias[jnp.asarray(bucket)].astype(f32), (2, 0, 1))
    s = s + bias.reshape(SWA_KV_HEADS, SWA_GROUP, L, 2 * L)
    blk_ok = (np.arange(nb)[:, None, None] > 0) | (np.arange(2 * L)[None, None, :] >= L)
    mask = valid[None] & blk_ok
    s = jnp.where(jnp.asarray(mask)[None, :, None, None], s, -1e30)
    sink = sinks.astype(f32).reshape(SWA_KV_HEADS, SWA_GROUP)[None, None, :, :, None, None]
    m = jnp.maximum(jnp.max(s, axis=-1, keepdims=True), sink)
    p = jnp.exp(s - m)
    p = p / (jnp.sum(p, axis=-1, keepdims=True) + jnp.exp(sink - m))
    o = jnp.einsum('bnhgqk,bnkhd->bnqhgd', p, vb.astype(f32))
    return o.reshape(B, S, SWA_Q).astype(q.dtype)


def hybrid_attention_mixer(h, w_in, gla_w_gate, gla_b_gate, gla_norm_w, sinks, rel_bias, w_out):
    B, S, _ = h.shape
    proj = h @ w_in
    offs = np.cumsum(IN_SPLITS)[:-1].tolist()
    gq, gk, gv, gg, glr, sq, sk, sv = jnp.split(proj, offs, axis=-1)
    gate_logits = (glr @ gla_w_gate + gla_b_gate).astype(jnp.float32)
    log_a = (jax.nn.log_sigmoid(gate_logits) / GLA_TAU).reshape(B, S, GLA_HEADS, GLA_DK)
    o_gla = gla_chunked(gq.reshape(B, S, GLA_HEADS, GLA_DK), gk.reshape(B, S, GLA_HEADS, GLA_DK),
                        gv.reshape(B, S, GLA_HEADS, GLA_DV), log_a).astype(h.dtype)
    o_gla = rms_norm(o_gla, gla_norm_w) * jax.nn.silu(gg.reshape(B, S, GLA_HEADS, GLA_DV))
    o_gla = o_gla.reshape(B, S, GLA_V)
    o_swa = sliding_window_attention(sq.reshape(B, S, SWA_HEADS, SWA_HEAD_DIM),
                                     sk.reshape(B, S, SWA_KV_HEADS, SWA_HEAD_DIM),
                                     sv.reshape(B, S, SWA_KV_HEADS, SWA_HEAD_DIM), rel_bias, sinks)
    return jnp.concatenate([o_gla, o_swa], axis=-1) @ w_out


def multiscale_pool_mixer(h, pool_w, pool_scale):
    B, S, _ = h.shape
    hf = h.astype(jnp.float32)
    cs = jnp.cumsum(hf, axis=1)
    t = jnp.arange(S)
    outs = []
    for gi, w in enumerate(POOL_WINDOWS):
        lo, hi = gi * POOL_GROUP, (gi + 1) * POOL_GROUP
        csg = cs[..., lo:hi]
        lag = jnp.pad(csg, ((0, 0), (w, 0), (0, 0)))[:, :S]
        cnt = jnp.minimum(t + 1, w).astype(jnp.float32)[None, :, None]
        pooled = (csg - lag) / cnt - hf[..., lo:hi]
        outs.append(pooled.astype(h.dtype) @ pool_w[gi])
    return jnp.concatenate(outs, axis=-1) * pool_scale


def squared_relu_mlp(h, w1, w2):
    return jnp.square(jax.nn.relu(h @ w1)) @ w2


def setup_inputs(seed: int = 0) -> dict:
    key = jax.random.key(seed)
    ks = jax.random.split(key, 17)
    f32 = jnp.float32
    nrm = lambda k, s: jax.random.normal(k, s, f32)
    return {
        "x": nrm(ks[0], (BATCH, SEQ, D_MODEL)),
        "c": nrm(ks[1], (BATCH, D_MODEL)),
        "norm_w": 1.0 + 0.05 * nrm(ks[2], (DEPTH, 2, D_MODEL)),
        "ada_w": nrm(ks[3], (DEPTH, 2, D_MODEL, 3 * D_MODEL)) * (0.5 * D_MODEL ** -0.5),
        "ada_b": 0.01 * nrm(ks[4], (DEPTH, 2, 3 * D_MODEL)),
        "attn_w_in": nrm(ks[5], (N_EVEN, D_MODEL, IN_COLS)) * D_MODEL ** -0.5,
        "gla_w_gate": nrm(ks[6], (N_EVEN, GLA_RANK, GLA_QK)) * GLA_RANK ** -0.5,
        "gla_b_gate": 0.1 * nrm(ks[7], (N_EVEN, GLA_QK)),
        "gla_norm_w": 1.0 + 0.05 * nrm(ks[8], (N_EVEN, GLA_DV)),
        "attn_sinks": 0.5 * nrm(ks[9], (N_EVEN, SWA_HEADS)),
        "attn_w_out": nrm(ks[10], (N_EVEN, MIX_OUT, D_MODEL)) * MIX_OUT ** -0.5,
        "rel_bias": 0.5 * nrm(ks[11], (N_BUCKETS, SWA_HEADS)),
        "pool_w": nrm(ks[12], (N_ODD, 4, POOL_GROUP, POOL_GROUP)) * POOL_GROUP ** -0.5,
        "pool_scale": 1.0 + 0.1 * nrm(ks[13], (N_ODD, D_MODEL)),
        "mlp_w1": nrm(ks[14], (DEPTH, D_MODEL, D_FF)) * D_MODEL ** -0.5,
        "mlp_w2": nrm(ks[15], (DEPTH, D_FF, D_MODEL)) * D_FF ** -0.5,
        "final_norm_w": 1.0 + 0.05 * nrm(ks[16], (D_MODEL,)),
    }


def reference(x, c, norm_w, ada_w, ada_b, attn_w_in, gla_w_gate, gla_b_gate, gla_norm_w,
              attn_sinks, attn_w_out, rel_bias, pool_w, pool_scale, mlp_w1, mlp_w2, final_norm_w):
    for layer in range(DEPTH):
        i = layer // 2
        shift, scale, gate = ada_modulation(c, ada_w[layer, 0], ada_b[layer, 0])
        h = rms_norm(x, norm_w[layer, 0]) * (1.0 + scale) + shift
        if layer % 2 == 0:
            y = hybrid_attention_mixer(h, attn_w_in[i], gla_w_gate[i], gla_b_gate[i], gla_norm_w[i],
                                       attn_sinks[i], rel_bias, attn_w_out[i])
        else:
            y = multiscale_pool_mixer(h, pool_w[i], pool_scale[i])
        x = x + (gate * y).astype(x.dtype)
        shift, scale, gate = ada_modulation(c, ada_w[layer, 1], ada_b[layer, 1])
        h = rms_norm(x, norm_w[layer, 1]) * (1.0 + scale) + shift
        x = x + (gate * squared_relu_mlp(h, mlp_w1[layer], mlp_w2[layer])).astype(x.dtype)
    return rms_norm(x, final_norm_w)
```

```cpp
#include <hip/hip_runtime.h>
#include <cstdio>
#include <cstdint>

#define LAS __attribute__((address_space(3)))
typedef unsigned short bf16_t;
typedef short bf16x8 __attribute__((ext_vector_type(8)));
typedef float f32x4 __attribute__((ext_vector_type(4)));
typedef float f32x2 __attribute__((ext_vector_type(2)));
typedef float f32x16 __attribute__((ext_vector_type(16)));
typedef unsigned u32x4 __attribute__((ext_vector_type(4)));
typedef unsigned u32x2 __attribute__((ext_vector_type(2)));
typedef __bf16 bf16x2_t __attribute__((ext_vector_type(2)));
#define DI __device__ __forceinline__

constexpr int NB = 4, SEQ = 8192, DM = 1024, MTOK = NB * SEQ, FF = 4096, NPROJ = 2560, INCOLS = 2320;
constexpr int PC_GQ = 0, PC_GK = 256, PC_GV = 512, PC_GG = 1024, PC_SQ = 1536, PC_SK = 2048, PC_SV = 2176, PC_GL = 2304;
constexpr float EPS = 1e-6f;
constexpr int NWAVES = 8, NTHR = 512;

constexpr size_t MiB = 1u << 20;
constexpr size_t WS_CTL = 0, CTL_ZERO_BYTES = 1 * MiB;
constexpr size_t WS_MOD = 1 * MiB;
constexpr size_t WS_WIN = 2 * MiB;
constexpr size_t WS_WOUT = 7 * MiB;
constexpr size_t WS_W1 = 9 * MiB;
constexpr size_t WS_W2 = 25 * MiB;
constexpr size_t WS_WP = 41 * MiB;
constexpr size_t WS_DEC = 42 * MiB;
constexpr size_t WS_H = 48 * MiB;
constexpr size_t WS_PROJ = 112 * MiB;
constexpr size_t WS_MIX = 272 * MiB;
constexpr size_t WS_DS = 336 * MiB;
constexpr size_t WS_HID = 112 * MiB;
constexpr size_t WS_POOL = 400 * MiB;
constexpr size_t WS_END = 464 * MiB;
constexpr int CW_BAR = 4096;

constexpr int RING_BYTES = 155648;
constexpr int MISC_OFF = RING_BYTES;
constexpr int LDS_BYTES = 163840;

DI unsigned cvtpk(float lo, float hi) { f32x2 v = {lo, hi}; bf16x2_t b = __builtin_convertvector(v, bf16x2_t); return __builtin_bit_cast(unsigned, b); }
DI float bflo(unsigned w) { return __uint_as_float(w << 16); }
DI float bfhi(unsigned w) { return __uint_as_float(w & 0xffff0000u); }
DI float bf2f(bf16_t u) { return __uint_as_float((unsigned)u << 16); }
DI float wave_sum(float v) {
#pragma unroll
    for (int o = 1; o < 64; o <<= 1) v += __shfl_xor(v, o);
    return v;
}
DI float silu_f(float x) { return x / (1.f + __expf(-x)); }
DI float logsigmoid_f(float x) { return fminf(x, 0.f) - __logf(1.f + __expf(-fabsf(x))); }

__device__ const unsigned char T5B[128] = {0,1,2,3,4,5,6,7,8,9,10,11,12,13,14,15,16,16,16,17,17,18,18,18,19,19,19,20,20,20,20,21,21,21,21,22,22,22,22,22,23,23,23,23,23,23,24,24,24,24,24,24,25,25,25,25,25,25,25,26,26,26,26,26,26,26,26,27,27,27,27,27,27,27,27,27,27,28,28,28,28,28,28,28,28,28,28,29,29,29,29,29,29,29,29,29,29,29,29,30,30,30,30,30,30,30,30,30,30,30,30,30,30,31,31,31,31,31,31,31,31,31,31,31,31,31,31,31};

namespace pg8 {
constexpr int BM = 256, BK = 64, HALF = 128, HTB = HALF * BK * 2, STAGE_BYTES = 8 * HTB, NXCD = 8, WGM = 8;
__host__ __device__ __forceinline__ int lds_byte(int r, int c) { const int st = (r >> 4) * 2 + (c >> 5), rr = r & 15, cc = c & 31, ob = rr * 64 + cc * 2; return st * 1024 + (ob ^ (((ob >> 9) & 1) << 5)); }
__host__ __device__ __forceinline__ void stage_rc(int b, int& R, int& C) { const int st = b / 1024, sb = b % 1024, swz = sb ^ (((sb >> 9) & 1) << 5); R = (st >> 1) * 16 + swz / 64; C = (st & 1) * 32 + (swz % 64) / 2; }
__host__ __device__ __forceinline__ int perm32(int rho) { const int n = rho >> 4, i = rho & 15; return 8 * (i >> 2) + 4 * n + (i & 3); }

struct Unit { int pm, pn; };
struct Gemm { const bf16_t* A; const bf16_t* Bt; int lda, ldb, K, a_pn_koff; };

struct StaticOrder {
    int nM, nN, nwg, G, c;
    __host__ __device__ void init(int M, int N, int G_, int c_) { nM = M / BM; nN = N / BM; nwg = nM * nN; G = G_; c = c_; }
    __host__ __device__ bool next(int i, Unit& u) const {
        const long L = (long)i * G + c; if (L >= nwg) return false;
        int wgid = (int)L; { const int q = nwg / NXCD, r = nwg % NXCD, xcd = wgid % NXCD, off = wgid / NXCD; wgid = (xcd < r ? xcd * (q + 1) : r * (q + 1) + (xcd - r) * q) + off; }
        const int nig = WGM * nN, gid = wgid / nig, fm = gid * WGM, gsz = (nM - fm) < WGM ? (nM - fm) : WGM;
        u.pm = fm + ((wgid % nig) % gsz); u.pn = (wgid % nig) / gsz; return true;
    }
};

template <int ACT  > struct EpiBf16 {
    static constexpr bool PERM = true;
    bf16_t* O; int ldc;
    __device__ __forceinline__ void operator()(const f32x4 (&acc)[2][2][4][2], const Unit& u, int wr, int wc, int fr, int fq) const {
        const int row0 = u.pm * BM + wr * 64 + fr; const int col0 = u.pn * BM + wc * 32 + 8 * fq;
#pragma unroll
        for (int ai = 0; ai < 2; ++ai)
#pragma unroll
            for (int m = 0; m < 4; ++m) { bf16_t* rowp = O + (size_t)(row0 + ai * HALF + m * 16) * ldc + col0;
#pragma unroll
                for (int bj = 0; bj < 2; ++bj) { f32x4 v0 = acc[ai][bj][m][0], v1 = acc[ai][bj][m][1];
                    if (ACT == 2) {
#pragma unroll
                        for (int e = 0; e < 4; ++e) { const float a = fmaxf(v0[e], 0.f), b = fmaxf(v1[e], 0.f); v0[e] = a * a; v1[e] = b * b; } }
                    u32x4 w; w.x = cvtpk(v0[0], v0[1]); w.y = cvtpk(v0[2], v0[3]); w.z = cvtpk(v1[0], v1[1]); w.w = cvtpk(v1[2], v1[3]);
                    *(u32x4*)(rowp + bj * HALF) = w; } }
    }
};
struct EpiResGate {
    static constexpr bool PERM = false;
    const float* base; float* out; const float* mod_ls; const float* colscale;
    __device__ __forceinline__ void operator()(const f32x4 (&acc)[2][2][4][2], const Unit& u, int wr, int wc, int fr, int fq) const {
        const int b = u.pm >> 5;
        const float* gate = mod_ls + (size_t)b * 3072 + 2048;
        const int col0 = u.pn * BM + wc * 32 + 4 * fq;
        f32x4 gv[2][2];
#pragma unroll
        for (int bj = 0; bj < 2; ++bj)
#pragma unroll
            for (int n = 0; n < 2; ++n) { gv[bj][n] = *(const f32x4*)(gate + col0 + bj * HALF + n * 16); if (colscale) gv[bj][n] = gv[bj][n] * *(const f32x4*)(colscale + col0 + bj * HALF + n * 16); }
#pragma unroll
        for (int ai = 0; ai < 2; ++ai)
#pragma unroll
            for (int m = 0; m < 4; ++m) { const size_t off = (size_t)(u.pm * BM + ai * HALF + wr * 64 + m * 16 + fr) * DM + col0;
#pragma unroll
                for (int bj = 0; bj < 2; ++bj)
#pragma unroll
                    for (int n = 0; n < 2; ++n) { const f32x4 bs = *(const f32x4*)(base + off + bj * HALF + n * 16); *(f32x4*)(out + off + bj * HALF + n * 16) = bs + gv[bj][n] * acc[ai][bj][m][n]; } }
    }
};

template <class Epi, bool ALIGN_EPI, bool SP2>
__device__ __forceinline__ void gemm_phase(LAS unsigned char* lds, const Gemm g, const StaticOrder& S, const Epi& E) {
    const int tid = threadIdx.x, wid = __builtin_amdgcn_readfirstlane(tid >> 6), lane = tid & 63, wr = wid >> 2, wc = wid & 3, fr = lane & 15, fq = lane >> 4;
    const int K = g.K, nt = K / BK;
    unsigned voffA[2], voffB[2];
#pragma unroll
    for (int i = 0; i < 2; ++i) { int R, C; stage_rc(tid * 16 + i * 8192, R, C); const int Rb = Epi::PERM ? ((R & ~31) + perm32(R & 31)) : R;
        voffA[i] = (unsigned)(R * g.lda + C) * 2u; voffB[i] = (unsigned)(Rb * g.ldb + C) * 2u; }
    const size_t kstep = (size_t)(BK * 2);
    const size_t hstepA = (size_t)HALF * g.lda * 2, hstepB = (size_t)HALF * g.ldb * 2;
    const size_t tstepA = 2 * hstepA, tstepB = 2 * hstepB;
    const unsigned ldsw = (unsigned)wid * 1024u;
    const int aoff = lds_byte(wr * 64 + fr, fq * 8), boff = lds_byte(wc * 32 + fr, fq * 8);
#define PG8_SA(b, h) (((b) * 2 + (h)) * HTB)
#define PG8_SB(b, h) ((4 + (b) * 2 + (h)) * HTB)
#define PG8_STAGE(bufoff, gbase, voff) do { _Pragma("unroll") for (int _i = 0; _i < 2; ++_i) \
        __builtin_amdgcn_global_load_lds((const unsigned*)((const char*)(gbase) + (voff)[_i]), (LAS unsigned*)(lds + (bufoff) + ldsw + _i * 8192), 16, 0, 0); } while (0)
#define PG8_LDA(dst, b, h) do { _Pragma("unroll") for (int m = 0; m < 4; ++m) _Pragma("unroll") for (int k = 0; k < 2; ++k) dst[m][k] = *(const LAS bf16x8*)(lds + PG8_SA(b, h) + aoff + m * 2048 + k * 1024); } while (0)
#define PG8_LDB(dst, b, h) do { _Pragma("unroll") for (int n = 0; n < 2; ++n) _Pragma("unroll") for (int k = 0; k < 2; ++k) dst[n][k] = *(const LAS bf16x8*)(lds + PG8_SB(b, h) + boff + n * 2048 + k * 1024); } while (0)
#define PG8_MMA(ai, bj, At, Bt) do { __builtin_amdgcn_s_setprio(1); _Pragma("unroll") for (int m = 0; m < 4; ++m) _Pragma("unroll") for (int n = 0; n < 2; ++n) _Pragma("unroll") for (int k = 0; k < 2; ++k) \
        acc[ai][bj][m][n] = __builtin_amdgcn_mfma_f32_16x16x32_bf16(Bt[n][k], At[m][k], acc[ai][bj][m][n], 0, 0, 0); __builtin_amdgcn_s_setprio(0); } while (0)
#define PG8_WAIT_V(n) asm volatile("s_waitcnt vmcnt(" #n ")" ::: "memory")
#define PG8_WAIT_L(n) asm volatile("s_waitcnt lgkmcnt(" #n ")" ::: "memory")
#define PG8_BAR __builtin_amdgcn_s_barrier()
#define PG8_SCHED __builtin_amdgcn_sched_barrier(0)
    Unit cur, nxt; int ui = 0;
    if (!S.next(0, cur)) return;
    f32x4 acc[2][2][4][2];
#pragma unroll
    for (int a = 0; a < 2; ++a)
#pragma unroll
        for (int b = 0; b < 2; ++b)
#pragma unroll
            for (int m = 0; m < 4; ++m)
#pragma unroll
                for (int n = 0; n < 2; ++n) acc[a][b][m][n] = (f32x4){0.f, 0.f, 0.f, 0.f};
    bf16x8 At[4][2], B0[2][2], B1[2][2];
    const char* cA = (const char*)g.A + (size_t)cur.pm * tstepA + (size_t)cur.pn * g.a_pn_koff * 2; const char* cB = (const char*)g.Bt + (size_t)cur.pn * tstepB;
    if constexpr (SP2) {
        PG8_STAGE(PG8_SB(0, 0), cB, voffB); PG8_STAGE(PG8_SB(0, 1), cB + hstepB, voffB); PG8_STAGE(PG8_SA(0, 0), cA, voffA); PG8_STAGE(PG8_SA(0, 1), cA + hstepA, voffA);
        if (wr == 1) PG8_BAR;
        PG8_WAIT_V(2); PG8_BAR;
        PG8_STAGE(PG8_SB(1, 0), cB + kstep, voffB); PG8_STAGE(PG8_SA(1, 0), cA + kstep, voffA); PG8_STAGE(PG8_SB(1, 1), cB + hstepB + kstep, voffB);
        PG8_WAIT_V(6); PG8_BAR;
    } else {
        PG8_STAGE(PG8_SB(0, 0), cB, voffB); PG8_STAGE(PG8_SA(0, 0), cA, voffA); PG8_STAGE(PG8_SB(0, 1), cB + hstepB, voffB); PG8_STAGE(PG8_SA(0, 1), cA + hstepA, voffA);
        if (wr == 1) PG8_BAR;
        PG8_WAIT_V(4); PG8_BAR;
        PG8_STAGE(PG8_SB(1, 0), cB + kstep, voffB); PG8_STAGE(PG8_SA(1, 0), cA + kstep, voffA); PG8_STAGE(PG8_SB(1, 1), cB + hstepB + kstep, voffB);
        PG8_WAIT_V(6); PG8_BAR;
    }
    for (;;) {
        const bool has_next = S.next(ui + 1, nxt);
        const char* nA = has_next ? (const char*)g.A + (size_t)nxt.pm * tstepA + (size_t)nxt.pn * g.a_pn_koff * 2 : cA; const char* nB = has_next ? (const char*)g.Bt + (size_t)nxt.pn * tstepB : cB;
        for (int t = 0; t < nt; t += 2) {
            const bool last = (t == nt - 2);
            const char* a1 = cA + (size_t)(t + 1) * kstep;
            const char* a2 = last ? nA : cA + (size_t)(t + 2) * kstep; const char* b2 = last ? nB : cB + (size_t)(t + 2) * kstep;
            const char* a3 = a2 + kstep; const char* b3 = b2 + kstep;
            if constexpr (SP2) {
            PG8_LDB(B0, 0, 0); PG8_LDB(B1, 0, 1); PG8_SCHED; PG8_LDA(At, 0, 0); PG8_STAGE(PG8_SA(1, 1), a1 + hstepA, voffA);
            PG8_WAIT_V(8); PG8_WAIT_L(0); PG8_BAR; PG8_MMA(0, 0, At, B0); PG8_MMA(0, 1, At, B1); PG8_BAR; PG8_SCHED;
            PG8_LDA(At, 0, 1); PG8_STAGE(PG8_SB(0, 0), b2, voffB); PG8_STAGE(PG8_SB(0, 1), b2 + hstepB, voffB); PG8_STAGE(PG8_SA(0, 0), a2, voffA);
            PG8_WAIT_V(8); PG8_WAIT_L(0); PG8_BAR; PG8_MMA(1, 0, At, B0); PG8_MMA(1, 1, At, B1); PG8_BAR; PG8_SCHED;
            PG8_LDB(B0, 1, 0); PG8_LDB(B1, 1, 1); PG8_SCHED; PG8_LDA(At, 1, 0); PG8_STAGE(PG8_SA(0, 1), a2 + hstepA, voffA);
            PG8_WAIT_V(8); PG8_WAIT_L(0); PG8_BAR; PG8_MMA(0, 0, At, B0); PG8_MMA(0, 1, At, B1); PG8_BAR; PG8_SCHED;
            PG8_LDA(At, 1, 1); PG8_STAGE(PG8_SB(1, 0), b3, voffB); PG8_STAGE(PG8_SB(1, 1), b3 + hstepB, voffB); PG8_STAGE(PG8_SA(1, 0), a3, voffA);
            PG8_WAIT_V(8); PG8_WAIT_L(0); PG8_BAR; PG8_MMA(1, 0, At, B0); PG8_MMA(1, 1, At, B1); PG8_BAR; PG8_SCHED;
            } else {
            PG8_LDB(B0, 0, 0); PG8_SCHED; PG8_LDA(At, 0, 0); PG8_STAGE(PG8_SA(1, 1), a1 + hstepA, voffA);
            PG8_WAIT_L(8); PG8_BAR; PG8_WAIT_L(0); PG8_MMA(0, 0, At, B0); PG8_BAR; PG8_SCHED;
            PG8_LDB(B1, 0, 1); PG8_STAGE(PG8_SB(0, 0), b2, voffB);
            PG8_BAR; PG8_WAIT_L(0); PG8_MMA(0, 1, At, B1); PG8_BAR;
            PG8_LDA(At, 0, 1); PG8_STAGE(PG8_SA(0, 0), a2, voffA);
            PG8_BAR; PG8_WAIT_L(0); PG8_MMA(1, 0, At, B0); PG8_BAR; PG8_SCHED;
            PG8_STAGE(PG8_SB(0, 1), b2 + hstepB, voffB);
            PG8_WAIT_V(6); PG8_BAR; PG8_MMA(1, 1, At, B1); PG8_BAR;
            PG8_LDB(B0, 1, 0); PG8_SCHED; PG8_LDA(At, 1, 0); PG8_STAGE(PG8_SA(0, 1), a2 + hstepA, voffA);
            PG8_WAIT_L(8); PG8_BAR; PG8_WAIT_L(0); PG8_MMA(0, 0, At, B0); PG8_BAR; PG8_SCHED;
            PG8_LDB(B1, 1, 1); PG8_STAGE(PG8_SB(1, 0), b3, voffB);
            PG8_BAR; PG8_WAIT_L(0); PG8_MMA(0, 1, At, B1); PG8_BAR;
            PG8_LDA(At, 1, 1); PG8_STAGE(PG8_SA(1, 0), a3, voffA);
            PG8_BAR; PG8_WAIT_L(0); PG8_MMA(1, 0, At, B0); PG8_BAR; PG8_SCHED;
            PG8_STAGE(PG8_SB(1, 1), b3 + hstepB, voffB);
            PG8_WAIT_V(6); PG8_BAR; PG8_MMA(1, 1, At, B1); PG8_BAR;
            }
        }
        if constexpr (ALIGN_EPI) { if (wr == 0) PG8_BAR; }
        E(acc, cur, wr, wc, fr, fq);
        if (!has_next) break;
#pragma unroll
        for (int a = 0; a < 2; ++a)
#pragma unroll
            for (int b = 0; b < 2; ++b)
#pragma unroll
                for (int m = 0; m < 4; ++m)
#pragma unroll
                    for (int n = 0; n < 2; ++n) acc[a][b][m][n] = (f32x4){0.f, 0.f, 0.f, 0.f};
        cur = nxt; cA = nA; cB = nB; ++ui;
        if constexpr (ALIGN_EPI) { if (wr == 1) PG8_BAR; }
    }
    PG8_WAIT_V(0);
    if constexpr (!ALIGN_EPI) { if (wr == 0) PG8_BAR; }
    PG8_BAR;
#undef PG8_SA
#undef PG8_SB
#undef PG8_STAGE
#undef PG8_LDA
#undef PG8_LDB
#undef PG8_MMA
#undef PG8_WAIT_V
#undef PG8_WAIT_L
#undef PG8_BAR
#undef PG8_SCHED
}
}

#define XB_TMO      128
#define XB_XCNT(j)  (256  + 64 * (j))
#define XB_XSUB(j)  (1280 + 64 * (j))
#define XB_XGEN(j)  (2304 + 64 * (j))
#define XB_TOP      3328
#define XB_TOPGEN   3392
#define XCD_BAR_WORDS 3456
#define XB_SPIN_CAP (1u << 18)
DI unsigned xb_ld(unsigned* p)              { return __hip_atomic_load(p, __ATOMIC_RELAXED, __HIP_MEMORY_SCOPE_AGENT); }
DI unsigned xb_add(unsigned* p, unsigned v) { return __hip_atomic_fetch_add(p, v, __ATOMIC_RELAXED, __HIP_MEMORY_SCOPE_AGENT); }
DI unsigned xb_xcc_id() { return (unsigned)__builtin_amdgcn_s_getreg((3 << 11) | 20) & 0xFu; }
#define XB_SPIN(cond, bar) do { unsigned _sp = 0; while (cond) { __builtin_amdgcn_s_sleep(1); \
    if ((++_sp & 255u) == 0u) { if (xb_ld(&(bar)[XB_TMO])) break; if (_sp > XB_SPIN_CAP) { atomicAdd(&(bar)[XB_TMO], 1u); break; } } } } while (0)
struct XcdBarrier { unsigned* bar; unsigned x; volatile LAS unsigned* st; };
DI XcdBarrier xcd_barrier_post(unsigned* bar, volatile LAS unsigned* st) {
    XcdBarrier b; b.bar = bar; b.x = xb_xcc_id(); b.st = st;
    if (threadIdx.x == 0) (void)xb_add(&bar[XB_XCNT(b.x)], 1u);
    return b;
}
DI void xcd_barrier_complete(unsigned* bar, unsigned x, unsigned& nloc, unsigned& nx) {
    const unsigned G = gridDim.x * gridDim.y * gridDim.z;
    unsigned sum, cnt, mine, sp = 0u;
    for (;;) {
        sum = 0u; cnt = 0u; mine = 0u;
#pragma unroll
        for (unsigned j = 0; j < 16; ++j) { const unsigned c = xb_ld(&bar[XB_XCNT(j)]); sum += c; cnt += (c > 0u) ? 1u : 0u; mine = (j == x) ? c : mine; }
        if (sum == G) break;
        __builtin_amdgcn_s_sleep(1);
        if ((++sp & 255u) == 0u) { if (xb_ld(&bar[XB_TMO])) break; if (sp > XB_SPIN_CAP) { atomicAdd(&bar[XB_TMO], 1u); break; } }
    }
    nloc = mine > 0u ? mine : 1u; nx = cnt > 0u ? cnt : 1u;
}
DI void xcd_barrier(const XcdBarrier& b) {
    asm volatile("s_waitcnt vmcnt(0)" ::: "memory");
    __syncthreads();
    if (threadIdx.x == 0) {
        unsigned* bar = b.bar;
        __builtin_amdgcn_s_waitcnt(0);
        unsigned nloc = b.st[0], nx = b.st[1];
        if (nloc == 0u) { xcd_barrier_complete(bar, b.x, nloc, nx); b.st[0] = nloc; b.st[1] = nx; }
        const unsigned old = xb_add(&bar[XB_XSUB(b.x)], 1u);
        const unsigned gen = old / nloc;
        if (old + 1u == (gen + 1u) * nloc) {
            __builtin_amdgcn_fence(__ATOMIC_RELEASE, "agent");
            asm volatile("s_waitcnt vmcnt(0)" ::: "memory");
            const unsigned og = xb_add(&bar[XB_TOP], 1u);
            const unsigned tg = og / nx;
            if (og + 1u == (tg + 1u) * nx) xb_add(&bar[XB_TOPGEN], 1u);
            else XB_SPIN(xb_ld(&bar[XB_TOPGEN]) == tg, bar);
            __builtin_amdgcn_fence(__ATOMIC_ACQUIRE, "agent");
            xb_add(&bar[XB_XGEN(b.x)], 1u);
            asm volatile("s_waitcnt vmcnt(0)" ::: "memory");
        } else {
            XB_SPIN(xb_ld(&bar[XB_XGEN(b.x)]) == gen, bar);
            __builtin_amdgcn_fence(__ATOMIC_ACQUIRE, "agent");
            asm volatile("s_waitcnt vmcnt(0)" ::: "memory");
        }
    }
    __syncthreads();
}

DI void p0_mod_unit(int unit, const float* c, const float* ada_w, const float* ada_b, float* MOD, LAS unsigned char* lds, int tid, int wave, int lane) {
    LAS float* sc = (LAS float*)lds;
    LAS float* red = (LAS float*)(lds + 16384);
    const int ls = unit / 48, j0 = (unit % 48) * 64;
    for (int k = tid; k < 1024; k += NTHR) {
#pragma unroll
        for (int b = 0; b < 4; ++b) sc[k * 4 + b] = silu_f(c[b * 1024 + k]);
    }
    __syncthreads();
    const float* w = ada_w + (size_t)ls * 1024 * 3072 + (size_t)(wave * 128) * 3072 + j0 + lane;
    float a0 = 0.f, a1 = 0.f, a2 = 0.f, a3 = 0.f;
#pragma unroll 8
    for (int k = 0; k < 128; ++k) { const float wv = w[(size_t)k * 3072]; const f32x4 s = *(const LAS f32x4*)(sc + (wave * 128 + k) * 4);
        a0 += wv * s[0]; a1 += wv * s[1]; a2 += wv * s[2]; a3 += wv * s[3]; }
    red[(wave * 4 + 0) * 64 + lane] = a0; red[(wave * 4 + 1) * 64 + lane] = a1; red[(wave * 4 + 2) * 64 + lane] = a2; red[(wave * 4 + 3) * 64 + lane] = a3;
    __syncthreads();
    if (wave < 4) { float s = ada_b[ls * 3072 + j0 + lane];
#pragma unroll
        for (int w8 = 0; w8 < 8; ++w8) s += red[(w8 * 4 + wave) * 64 + lane];
        MOD[((size_t)ls * 4 + wave) * 3072 + j0 + lane] = s; }
    __syncthreads();
}
DI void p0_transpose_item(const float* W, int ldw, int src_col0, bf16_t* WT, int K, int dst_row0, int k0, LAS float* scr, int lane) {
#pragma unroll 8
    for (int i = 0; i < 32; ++i) { const int kk = 2 * i + (lane >> 5); scr[kk * 33 + (lane & 31)] = W[(size_t)(k0 + kk) * ldw + src_col0 + (lane & 31)]; }
    asm volatile("s_waitcnt lgkmcnt(0)" ::: "memory");
    const int c = lane & 7;
#pragma unroll
    for (int j = 0; j < 4; ++j) { const int n = (lane >> 3) + 8 * j; const LAS float* s = scr + (8 * c) * 33 + n;
        u32x4 o; o.x = cvtpk(s[0 * 33], s[1 * 33]); o.y = cvtpk(s[2 * 33], s[3 * 33]); o.z = cvtpk(s[4 * 33], s[5 * 33]); o.w = cvtpk(s[6 * 33], s[7 * 33]);
        *(u32x4*)(WT + (size_t)(dst_row0 + n) * K + k0 + 8 * c) = o; }
    asm volatile("s_waitcnt lgkmcnt(0)" ::: "memory");
}
DI void p0_gatefold_item(const float* Win, const float* wgate, bf16_t* WT, int n0, int k0, LAS float* scr, int lane) {
    const int nn = lane & 31;
    float wg[16];
#pragma unroll
    for (int r = 0; r < 16; ++r) wg[r] = wgate[r * 256 + n0 + nn];
    for (int i = 0; i < 32; ++i) { const int kk = 2 * i + (lane >> 5); const float* src = Win + (size_t)(k0 + kk) * INCOLS + 1536; float s = 0.f;
#pragma unroll
        for (int r = 0; r < 16; ++r) s += src[r] * wg[r];
        scr[kk * 33 + nn] = s; }
    asm volatile("s_waitcnt lgkmcnt(0)" ::: "memory");
    const int c = lane & 7;
#pragma unroll
    for (int j = 0; j < 4; ++j) { const int n = (lane >> 3) + 8 * j; const LAS float* s = scr + (8 * c) * 33 + n;
        u32x4 o; o.x = cvtpk(s[0 * 33], s[1 * 33]); o.y = cvtpk(s[2 * 33], s[3 * 33]); o.z = cvtpk(s[4 * 33], s[5 * 33]); o.w = cvtpk(s[6 * 33], s[7 * 33]);
        *(u32x4*)(WT + (size_t)(PC_GL + n0 + n) * 1024 + k0 + 8 * c) = o; }
    asm volatile("s_waitcnt lgkmcnt(0)" ::: "memory");
}
DI void norm_rows(const float* X, bf16_t* Hout, const float* nw, const float* mod_ls, int gw, int NGW, int lane) {
    for (int m = gw; m < MTOK; m += NGW) {
        const int b = m >> 13;
        const f32x4* xr = (const f32x4*)(X + (size_t)m * DM) + lane;
        const f32x4* nwp = (const f32x4*)nw + lane; const f32x4* shp = (const f32x4*)(mod_ls + (size_t)b * 3072) + lane; const f32x4* scp = (const f32x4*)(mod_ls + (size_t)b * 3072 + 1024) + lane;
        f32x4 v[4]; float s = 0.f;
#pragma unroll
        for (int j = 0; j < 4; ++j) { v[j] = xr[64 * j]; s += (v[j].x * v[j].x + v[j].y * v[j].y) + (v[j].z * v[j].z + v[j].w * v[j].w); }
        const float rstd = rsqrtf(wave_sum(s) * (1.f / DM) + EPS);
        u32x2* o8 = (u32x2*)(Hout + (size_t)m * DM) + lane;
#pragma unroll
        for (int j = 0; j < 4; ++j) { const f32x4 g = nwp[64 * j] * (scp[64 * j] + 1.0f), sh = shp[64 * j]; const f32x4 h = v[j] * rstd * g + sh;
            u32x2 w; w.x = cvtpk(h.x, h.y); w.y = cvtpk(h.z, h.w); o8[64 * j] = w; }
    }
}
DI void final_norm_rows(float* X, const float* fw, int gw, int NGW, int lane) {
    for (int m = gw; m < MTOK; m += NGW) {
        f32x4* xr = (f32x4*)(X + (size_t)m * DM) + lane; const f32x4* fwp = (const f32x4*)fw + lane;
        f32x4 v[4]; float s = 0.f;
#pragma unroll
        for (int j = 0; j < 4; ++j) { v[j] = xr[64 * j]; s += (v[j].x * v[j].x + v[j].y * v[j].y) + (v[j].z * v[j].z + v[j].w * v[j].w); }
        const float rstd = rsqrtf(wave_sum(s) * (1.f / DM) + EPS);
#pragma unroll
        for (int j = 0; j < 4; ++j) xr[64 * j] = v[j] * rstd * fwp[64 * j];
    }
}
DI void gla_naive_rec(int wg, const bf16_t* PROJ, const float* bgate, float* OG, int tid) {
    const int b = wg >> 2, h = wg & 3, e = tid >> 2, dq = tid & 3;
    float S[16], bg[16];
#pragma unroll
    for (int i = 0; i < 16; ++i) bg[i] = bgate[h * 64 + 16 * dq + i];
#pragma unroll
    for (int i = 0; i < 16; ++i) S[i] = 0.f;
    const bf16_t* row = PROJ + (size_t)(b * SEQ) * NPROJ;
    for (int t = 0; t < SEQ; ++t, row += NPROJ) {
        const u32x4* lgp = (const u32x4*)(row + PC_GL + h * 64 + 16 * dq); const u32x4* kp = (const u32x4*)(row + PC_GK + h * 64 + 16 * dq); const u32x4* qp = (const u32x4*)(row + PC_GQ + h * 64 + 16 * dq);
        const u32x4 l0 = lgp[0], l1 = lgp[1], k0 = kp[0], k1 = kp[1], q0 = qp[0], q1 = qp[1];
        const float v = bf2f(row[PC_GV + h * 128 + e]);
        float lg[16], kk[16], qq[16];
#pragma unroll
        for (int i = 0; i < 4; ++i) { lg[2 * i] = bflo(l0[i]); lg[2 * i + 1] = bfhi(l0[i]); lg[8 + 2 * i] = bflo(l1[i]); lg[8 + 2 * i + 1] = bfhi(l1[i]);
            kk[2 * i] = bflo(k0[i]); kk[2 * i + 1] = bfhi(k0[i]); kk[8 + 2 * i] = bflo(k1[i]); kk[8 + 2 * i + 1] = bfhi(k1[i]);
            qq[2 * i] = bflo(q0[i]); qq[2 * i + 1] = bfhi(q0[i]); qq[8 + 2 * i] = bflo(q1[i]); qq[8 + 2 * i + 1] = bfhi(q1[i]); }
        float o = 0.f;
#pragma unroll
        for (int i = 0; i < 16; ++i) { const float a = __expf(logsigmoid_f(lg[i] + bg[i]) * (1.f / 16.f)); S[i] = a * S[i] + kk[i] * v; o += qq[i] * S[i]; }
        o += __shfl_xor(o, 1); o += __shfl_xor(o, 2);
        if (dq == 0) OG[(size_t)(b * SEQ + t) * 512 + h * 128 + e] = o * 0.125f;
    }
}
DI void gla_norm_gate(const float* OG, const bf16_t* PROJ, const float* gnw, bf16_t* MIX, int gw, int NGW, int lane) {
    const f32x2 g = *((const f32x2*)gnw + lane);
    for (int it = gw; it < MTOK * 4; it += NGW) {
        const int tok = it >> 2, h = it & 3;
        const f32x2 o = *((const f32x2*)(OG + (size_t)tok * 512 + h * 128) + lane);
        const float rstd = rsqrtf(wave_sum(o.x * o.x + o.y * o.y) * (1.f / 128.f) + EPS);
        const unsigned gg = *((const unsigned*)(PROJ + (size_t)tok * NPROJ + PC_GG + h * 128) + lane);
        const float y0 = o.x * rstd * g.x * silu_f(bflo(gg)), y1 = o.y * rstd * g.y * silu_f(bfhi(gg));
        *((unsigned*)(MIX + (size_t)tok * DM + h * 128) + lane) = cvtpk(y0, y1);
    }
}
DI void swa_naive(long gid, const bf16_t* PROJ, const float* rel_bias, const float* sinks, bf16_t* MIX) {
    const int t = (int)(gid & (SEQ - 1)), head = (int)((gid >> 13) & 7), b = (int)(gid >> 16), kvh = head >> 2;
    const bf16_t* base = PROJ + (size_t)(b * SEQ) * NPROJ;
    float q[64], o[64];
    { const u32x4* qp = (const u32x4*)(base + (size_t)t * NPROJ + PC_SQ + head * 64);
#pragma unroll
      for (int i = 0; i < 8; ++i) { const u32x4 w = qp[i];
#pragma unroll
          for (int j = 0; j < 4; ++j) { q[8 * i + 2 * j] = bflo(w[j]) * 0.125f; q[8 * i + 2 * j + 1] = bfhi(w[j]) * 0.125f; } } }
#pragma unroll
    for (int i = 0; i < 64; ++i) o[i] = 0.f;
    float m = sinks[head], l = 1.f;
    for (int dist = 127; dist >= 0; --dist) {
        const int tk = t - dist; if (tk < 0) continue;
        const u32x4* kp = (const u32x4*)(base + (size_t)tk * NPROJ + PC_SK + kvh * 64); const u32x4* vp = (const u32x4*)(base + (size_t)tk * NPROJ + PC_SV + kvh * 64);
        float s = 0.f;
#pragma unroll
        for (int i = 0; i < 8; ++i) { const u32x4 w = kp[i];
#pragma unroll
            for (int j = 0; j < 4; ++j) { s += q[8 * i + 2 * j] * bflo(w[j]); s += q[8 * i + 2 * j + 1] * bfhi(w[j]); } }
        s += rel_bias[T5B[dist] * 8 + head];
        const float mn = fmaxf(m, s), alpha = __expf(m - mn), p = __expf(s - mn);
        l = l * alpha + p; m = mn;
#pragma unroll
        for (int i = 0; i < 8; ++i) { const u32x4 w = vp[i];
#pragma unroll
            for (int j = 0; j < 4; ++j) { o[8 * i + 2 * j] = o[8 * i + 2 * j] * alpha + p * bflo(w[j]); o[8 * i + 2 * j + 1] = o[8 * i + 2 * j + 1] * alpha + p * bfhi(w[j]); } }
    }
    const float rl = 1.f / l;
    u32x4* op = (u32x4*)(MIX + (size_t)(b * SEQ + t) * DM + 512 + head * 64);
#pragma unroll
    for (int i = 0; i < 8; ++i) { u32x4 w;
#pragma unroll
        for (int j = 0; j < 4; ++j) w[j] = cvtpk(o[8 * i + 2 * j] * rl, o[8 * i + 2 * j + 1] * rl);
        op[i] = w; }
}
DI void pool_tile(int tile, const float* X, bf16_t* POOL, const float* nw, const float* mod_ls, LAS unsigned char* lds, int tid, int wave, int lane) {
    LAS float* rs = (LAS float*)lds;
    const int b = tile >> 6, t0 = (tile & 63) * 128;
    for (int ri = wave; ri < 143; ri += NWAVES) { const int t = t0 - 15 + ri; if (t < 0) continue;
        const f32x4* xr = (const f32x4*)(X + (size_t)(b * SEQ + t) * DM) + lane; float s = 0.f;
#pragma unroll
        for (int j = 0; j < 4; ++j) { const f32x4 v = xr[64 * j]; s += (v.x * v.x + v.y * v.y) + (v.z * v.z + v.w * v.w); }
        s = wave_sum(s); if (lane == 0) rs[ri] = rsqrtf(s * (1.f / DM) + EPS); }
    __syncthreads();
    const int c0 = 2 * tid, w = 2 << (wave >> 1);
    const f32x2 g = *(const f32x2*)(nw + c0) * (*(const f32x2*)(mod_ls + (size_t)b * 3072 + 1024 + c0) + 1.0f), sh = *(const f32x2*)(mod_ls + (size_t)b * 3072 + c0);
    f32x2 ring[16];
#pragma unroll
    for (int i = 0; i < 16; ++i) ring[i] = (f32x2){0.f, 0.f};
    for (int base = 0; base < 144; base += 16) {
#pragma unroll
        for (int u = 0; u < 16; ++u) { const int ri = base + u, t = t0 - 15 + ri;
            f32x2 val = (f32x2){0.f, 0.f};
            if (ri < 143 && t >= 0) { const f32x2 x = *(const f32x2*)(X + (size_t)(b * SEQ + t) * DM + c0); val = x * rs[ri] * g + sh; }
            ring[u] = val;
            if (ri >= 15 && ri < 143) { f32x2 sum = (f32x2){0.f, 0.f};
#pragma unroll
                for (int j = 0; j < 16; ++j) if (j < w) sum += ring[(u - j) & 15];
                const float cnt = (float)((t + 1 < w) ? t + 1 : w); const f32x2 p = sum * (1.f / cnt) - val;
                *(unsigned*)(POOL + (size_t)(b * SEQ + t) * DM + c0) = cvtpk(p.x, p.y); }
        }
    }
    __syncthreads();
}

struct Args { const float* in[17]; float* out; unsigned char* ws; int ph_lo, ph_hi, use_bar, pad; };
enum { I_X = 0, I_C, I_NORMW, I_ADAW, I_ADAB, I_WIN, I_WGATE, I_BGATE, I_GNW, I_SINKS, I_WOUT, I_RELB, I_POOLW, I_POOLS, I_W1, I_W2, I_FNW };
constexpr int NPHASE = 16;

__global__ void __launch_bounds__(NTHR, 2) mk_fwd(Args args) {
    extern __shared__ __attribute__((aligned(16))) unsigned char lds_raw[];
    LAS unsigned char* lds = (LAS unsigned char*)lds_raw;
    volatile LAS unsigned* MISC = (volatile LAS unsigned*)(lds + MISC_OFF);
    const int tid = threadIdx.x, lane = tid & 63, wave = __builtin_amdgcn_readfirstlane(tid >> 6);
    const int G = gridDim.x, bx = blockIdx.x;
    const int vcu = (G % 8 == 0) ? (bx % 8) * (G / 8) + bx / 8 : bx;
    const int gw = vcu * NWAVES + wave, NGW = G * NWAVES;
    unsigned char* ws = args.ws;
    unsigned* ctl = (unsigned*)(ws + WS_CTL);
    float* MOD = (float*)(ws + WS_MOD);
    bf16_t* WIN_T = (bf16_t*)(ws + WS_WIN); bf16_t* WOUT_T = (bf16_t*)(ws + WS_WOUT); bf16_t* W1_T = (bf16_t*)(ws + WS_W1); bf16_t* W2_T = (bf16_t*)(ws + WS_W2); bf16_t* WP_T = (bf16_t*)(ws + WS_WP);
    bf16_t* H = (bf16_t*)(ws + WS_H); bf16_t* PROJ = (bf16_t*)(ws + WS_PROJ); bf16_t* MIX = (bf16_t*)(ws + WS_MIX); bf16_t* HID = (bf16_t*)(ws + WS_HID); bf16_t* POOL = (bf16_t*)(ws + WS_POOL);
    float* DS = (float*)(ws + WS_DS);
    const float* x = args.in[I_X]; float* X1 = args.out;

    if (tid < 64) MISC[tid] = 0u;
    __syncthreads();
    XcdBarrier bar; bar.bar = ctl + CW_BAR; bar.x = 0; bar.st = nullptr;
    if (args.use_bar) bar = xcd_barrier_post(ctl + CW_BAR, MISC + 8);
    const int lo = args.ph_lo, hi = args.ph_hi;
#define IN(k) (lo <= (k) && (k) < hi)
#define SEAM(k) do { if (IN(k) && IN((k) + 1)) xcd_barrier(bar); } while (0)

    if (IN(0)) {
        if (bx < 192) p0_mod_unit(bx, args.in[I_C], args.in[I_ADAW], args.in[I_ADAB], MOD, lds, tid, wave, lane);
        LAS float* scr = (LAS float*)(lds + wave * 16384);
        constexpr int I_IN = 16 * 72, I_GF = 16 * 8, I_OUT = 16 * 32, I_1 = 16 * 128, I_2 = 64 * 32, I_P = 4 * 8;
        constexpr int NITEMS = I_IN + I_GF + I_OUT + 2 * I_1 + 2 * I_2 + 4 * I_P;
        for (int it = gw; it < NITEMS; it += NGW) {
            int r = it;
            if (r < I_IN) { const int kb = r / 72, nb = r % 72, n0 = nb * 32; p0_transpose_item(args.in[I_WIN], INCOLS, n0 < 1536 ? n0 : n0 + 16, WIN_T, 1024, n0, kb * 64, scr, lane); continue; } r -= I_IN;
            if (r < I_GF) { const int kb = r / 8, nb = r % 8; p0_gatefold_item(args.in[I_WIN], args.in[I_WGATE], WIN_T, nb * 32, kb * 64, scr, lane); continue; } r -= I_GF;
            if (r < I_OUT) { const int kb = r / 32, nb = r % 32; p0_transpose_item(args.in[I_WOUT], 1024, nb * 32, WOUT_T, 1024, nb * 32, kb * 64, scr, lane); continue; } r -= I_OUT;
            if (r < 2 * I_1) { const int l = r / I_1; r -= l * I_1; const int kb = r / 128, nb = r % 128; p0_transpose_item(args.in[I_W1] + (size_t)l * 1024 * 4096, 4096, nb * 32, W1_T + (size_t)l * 4096 * 1024, 1024, nb * 32, kb * 64, scr, lane); continue; } r -= 2 * I_1;
            if (r < 2 * I_2) { const int l = r / I_2; r -= l * I_2; const int kb = r / 32, nb = r % 32; p0_transpose_item(args.in[I_W2] + (size_t)l * 4096 * 1024, 1024, nb * 32, W2_T + (size_t)l * 1024 * 4096, 4096, nb * 32, kb * 64, scr, lane); continue; } r -= 2 * I_2;
            { const int gi = r / I_P; r -= gi * I_P; const int kb = r / 8, nb = r % 8; p0_transpose_item(args.in[I_POOLW] + (size_t)gi * 65536, 256, nb * 32, WP_T + (size_t)gi * 65536, 256, nb * 32, kb * 64, scr, lane); }
        }
    }
    SEAM(0);
    if (IN(1)) norm_rows(x, H, args.in[I_NORMW] + 0 * 1024, MOD + 0 * 4 * 3072, gw, NGW, lane);
    SEAM(1);
    if (IN(2)) { pg8::Gemm g{H, WIN_T, 1024, 1024, 1024, 0}; pg8::StaticOrder S; S.init(MTOK, NPROJ, G, bx);
        pg8::EpiBf16<0> E{PROJ, NPROJ}; pg8::gemm_phase<pg8::EpiBf16<0>, true, true>(lds, g, S, E); }
    SEAM(2);
    if (IN(3)) {
        if (bx < 16) gla_naive_rec(bx, PROJ, args.in[I_BGATE], DS, tid);
        else { for (long it = bx - 16; it < 512; it += G - 16) swa_naive(it * NTHR + tid, PROJ, args.in[I_RELB], args.in[I_SINKS], MIX); }
    }
    SEAM(3);
    if (IN(4)) gla_norm_gate(DS, PROJ, args.in[I_GNW], MIX, gw, NGW, lane);
    SEAM(4);
    SEAM(5);
    if (IN(6)) { pg8::Gemm g{MIX, WOUT_T, 1024, 1024, 1024, 0}; pg8::StaticOrder S; S.init(MTOK, DM, G, bx);
        pg8::EpiResGate E{x, X1, MOD + 0 * 4 * 3072, nullptr}; pg8::gemm_phase<pg8::EpiResGate, true, true>(lds, g, S, E); }
    SEAM(6);
    if (IN(7)) norm_rows(X1, H, args.in[I_NORMW] + 1 * 1024, MOD + 1 * 4 * 3072, gw, NGW, lane);
    SEAM(7);
    if (IN(8)) { pg8::Gemm g{H, W1_T, 1024, 1024, 1024, 0}; pg8::StaticOrder S; S.init(MTOK, FF, G, bx);
        pg8::EpiBf16<2> E{HID, FF}; pg8::gemm_phase<pg8::EpiBf16<2>, true, true>(lds, g, S, E); }
    SEAM(8);
    if (IN(9)) { pg8::Gemm g{HID, W2_T, 4096, 4096, 4096, 0}; pg8::StaticOrder S; S.init(MTOK, DM, G, bx);
        pg8::EpiResGate E{X1, X1, MOD + 1 * 4 * 3072, nullptr}; pg8::gemm_phase<pg8::EpiResGate, true, true>(lds, g, S, E); }
    SEAM(9);
    if (IN(10)) { for (int tile = bx; tile < 256; tile += G) pool_tile(tile, X1, POOL, args.in[I_NORMW] + 2 * 1024, MOD + 2 * 4 * 3072, lds, tid, wave, lane); }
    SEAM(10);
    if (IN(11)) { pg8::Gemm g{POOL, WP_T, 1024, 256, 256, 256}; pg8::StaticOrder S; S.init(MTOK, DM, G, bx);
        pg8::EpiResGate E{X1, X1, MOD + 2 * 4 * 3072, args.in[I_POOLS]}; pg8::gemm_phase<pg8::EpiResGate, true, true>(lds, g, S, E); }
    SEAM(11);
    if (IN(12)) norm_rows(X1, H, args.in[I_NORMW] + 3 * 1024, MOD + 3 * 4 * 3072, gw, NGW, lane);
    SEAM(12);
    if (IN(13)) { pg8::Gemm g{H, W1_T + (size_t)4096 * 1024, 1024, 1024, 1024, 0}; pg8::StaticOrder S; S.init(MTOK, FF, G, bx);
        pg8::EpiBf16<2> E{HID, FF}; pg8::gemm_phase<pg8::EpiBf16<2>, true, true>(lds, g, S, E); }
    SEAM(13);
    if (IN(14)) { pg8::Gemm g{HID, W2_T + (size_t)1024 * 4096, 4096, 4096, 4096, 0}; pg8::StaticOrder S; S.init(MTOK, DM, G, bx);
        pg8::EpiResGate E{X1, X1, MOD + 3 * 4 * 3072, nullptr}; pg8::gemm_phase<pg8::EpiResGate, true, true>(lds, g, S, E); }
    SEAM(14);
    if (IN(15)) final_norm_rows(X1, args.in[I_FNW], gw, NGW, lane);
#undef IN
#undef SEAM
}

#ifndef MK_N_LAUNCHES
#define MK_N_LAUNCHES 1
#endif
extern "C" void kernel_launch(void* const* d_in, const int* in_sizes, int n_in, void* d_out, int out_size, void* d_ws, size_t ws_size, hipStream_t stream) {
    static int grid = 0;
    if (grid == 0) {
        if (n_in != 17 || in_sizes[0] != MTOK * DM || out_size != MTOK * DM || ws_size < WS_END) { fprintf(stderr, "kernel_launch: unexpected shapes (n_in %d, in0 %d, out %d, ws %zu)\n", n_in, n_in > 0 ? in_sizes[0] : -1, out_size, ws_size); grid = -1; return; }
        int dev = 0, cus = 0, per_cu = 0;
        if (hipGetDevice(&dev) != hipSuccess || hipDeviceGetAttribute(&cus, hipDeviceAttributeMultiprocessorCount, dev) != hipSuccess) { grid = -1; return; }
        if (hipFuncSetAttribute((const void*)mk_fwd, hipFuncAttributeMaxDynamicSharedMemorySize, LDS_BYTES) != hipSuccess) { fprintf(stderr, "kernel_launch: hipFuncSetAttribute failed\n"); grid = -1; return; }
        if (hipOccupancyMaxActiveBlocksPerMultiprocessor(&per_cu, (const void*)mk_fwd, NTHR, LDS_BYTES) != hipSuccess || per_cu < 1) { fprintf(stderr, "kernel_launch: occupancy query says %d\n", per_cu); per_cu = 1; }
        (void)hipGetLastError();
        grid = cus;
    }
    if (grid < 0) return;
    (void)hipMemsetAsync((char*)d_ws + WS_CTL, 0, CTL_ZERO_BYTES, stream);
    Args a{};
    for (int i = 0; i < 17; ++i) a.in[i] = (const float*)d_in[i];
    a.out = (float*)d_out; a.ws = (unsigned char*)d_ws;
#if MK_N_LAUNCHES == 1
    a.ph_lo = 0; a.ph_hi = NPHASE; a.use_bar = 1;
    void* kargs[] = {&a};
    hipError_t e = hipLaunchCooperativeKernel((const void*)mk_fwd, dim3(grid), dim3(NTHR), kargs, LDS_BYTES, stream);
    if (e != hipSuccess) fprintf(stderr, "kernel_launch: cooperative launch failed: %s\n", hipGetErrorString(e));
#else
    for (int p = 0; p < NPHASE; ++p) { if (p == 5) continue; a.ph_lo = p; a.ph_hi = p + 1; a.use_bar = 0;
        hipLaunchKernelGGL(mk_fwd, dim3(grid), dim3(NTHR), LDS_BYTES, stream, a); }
#endif
}
```

```cpp
#include <hip/hip_runtime.h>
#include <cstdio>
#include <cstdint>

#define LAS __attribute__((address_space(3)))
typedef unsigned short bf16_t;
typedef short bf16x8 __attribute__((ext_vector_type(8)));
typedef float f32x4 __attribute__((ext_vector_type(4)));
typedef float f32x2 __attribute__((ext_vector_type(2)));
typedef float f32x16 __attribute__((ext_vector_type(16)));
typedef unsigned u32x4 __attribute__((ext_vector_type(4)));
typedef unsigned u32x2 __attribute__((ext_vector_type(2)));
typedef __bf16 bf16x2_t __attribute__((ext_vector_type(2)));
#define DI __device__ __forceinline__

constexpr int NB = 4, SEQ = 8192, DM = 1024, MTOK = NB * SEQ, FF = 4096, NPROJ = 2560, INCOLS = 2320;
constexpr int PC_GQ = 0, PC_GK = 256, PC_GV = 512, PC_GG = 1024, PC_SQ = 1536, PC_SK = 2048, PC_SV = 2176, PC_GL = 2304;
constexpr float EPS = 1e-6f;
constexpr int NWAVES = 8, NTHR = 512;

constexpr size_t MiB = 1u << 20;
constexpr size_t WS_CTL = 0, CTL_ZERO_BYTES = 1 * MiB;
constexpr size_t WS_MOD = 1 * MiB;
constexpr size_t WS_WIN = 2 * MiB;
constexpr size_t WS_WOUT = 7 * MiB;
constexpr size_t WS_W1 = 9 * MiB;
constexpr size_t WS_W2 = 25 * MiB;
constexpr size_t WS_WP = 41 * MiB;
constexpr size_t WS_DEC = 42 * MiB;
constexpr size_t WS_H = 48 * MiB;
constexpr size_t WS_PROJ = 112 * MiB;
constexpr size_t WS_MIX = 272 * MiB;
constexpr size_t WS_DS = 336 * MiB;
constexpr size_t WS_HID = 112 * MiB;
constexpr size_t WS_POOL = 400 * MiB;
constexpr size_t WS_END = 464 * MiB;
constexpr int CW_BAR = 4096;

constexpr int RING_BYTES = 155648;
constexpr int MISC_OFF = RING_BYTES;
constexpr int LDS_BYTES = 163840;

DI unsigned cvtpk(float lo, float hi) { f32x2 v = {lo, hi}; bf16x2_t b = __builtin_convertvector(v, bf16x2_t); return __builtin_bit_cast(unsigned, b); }
DI float bflo(unsigned w) { return __uint_as_float(w << 16); }
DI float bfhi(unsigned w) { return __uint_as_float(w & 0xffff0000u); }
DI float bf2f(bf16_t u) { return __uint_as_float((unsigned)u << 16); }
DI float wave_sum(float v) {
#pragma unroll
    for (int o = 1; o < 64; o <<= 1) v += __shfl_xor(v, o);
    return v;
}
DI float silu_f(float x) { return x / (1.f + __expf(-x)); }
DI float logsigmoid_f(float x) { return fminf(x, 0.f) - __logf(1.f + __expf(-fabsf(x))); }

__device__ const unsigned char T5B[128] = {0,1,2,3,4,5,6,7,8,9,10,11,12,13,14,15,16,16,16,17,17,18,18,18,19,19,19,20,20,20,20,21,21,21,21,22,22,22,22,22,23,23,23,23,23,23,24,24,24,24,24,24,25,25,25,25,25,25,25,26,26,26,26,26,26,26,26,27,27,27,27,27,27,27,27,27,27,28,28,28,28,28,28,28,28,28,28,29,29,29,29,29,29,29,29,29,29,29,29,30,30,30,30,30,30,30,30,30,30,30,30,30,30,31,31,31,31,31,31,31,31,31,31,31,31,31,31,31};

namespace pg8 {
constexpr int BM = 256, BK = 64, HALF = 128, HTB = HALF * BK * 2, STAGE_BYTES = 8 * HTB, NXCD = 8, WGM = 8;
__host__ __device__ __forceinline__ int lds_byte(int r, int c) { const int st = (r >> 4) * 2 + (c >> 5), rr = r & 15, cc = c & 31, ob = rr * 64 + cc * 2; return st * 1024 + (ob ^ (((ob >> 9) & 1) << 5)); }
__host__ __device__ __forceinline__ void stage_rc(int b, int& R, int& C) { const int st = b / 1024, sb = b % 1024, swz = sb ^ (((sb >> 9) & 1) << 5); R = (st >> 1) * 16 + swz / 64; C = (st & 1) * 32 + (swz % 64) / 2; }
__host__ __device__ __forceinline__ int perm32(int rho) { const int n = rho >> 4, i = rho & 15; return 8 * (i >> 2) + 4 * n + (i & 3); }

struct Unit { int pm, pn; };
struct Gemm { const bf16_t* A; const bf16_t* Bt; int lda, ldb, K, a_pn_koff; };

struct StaticOrder {
    int nM, nN, nwg, G, c;
    __host__ __device__ void init(int M, int N, int G_, int c_) { nM = M / BM; nN = N / BM; nwg = nM * nN; G = G_; c = c_; }
    __host__ __device__ bool next(int i, Unit& u) const {
        const long L = (long)i * G + c; if (L >= nwg) return false;
        int wgid = (int)L; { const int q = nwg / NXCD, r = nwg % NXCD, xcd = wgid % NXCD, off = wgid / NXCD; wgid = (xcd < r ? xcd * (q + 1) : r * (q + 1) + (xcd - r) * q) + off; }
        const int nig = WGM * nN, gid = wgid / nig, fm = gid * WGM, gsz = (nM - fm) < WGM ? (nM - fm) : WGM;
        u.pm = fm + ((wgid % nig) % gsz); u.pn = (wgid % nig) / gsz; return true;
    }
};

template <int ACT  > struct EpiBf16 {
    static constexpr bool PERM = true;
    bf16_t* O; int ldc;
    __device__ __forceinline__ void operator()(const f32x4 (&acc)[2][2][4][2], const Unit& u, int wr, int wc, int fr, int fq) const {
        const int row0 = u.pm * BM + wr * 64 + fr; const int col0 = u.pn * BM + wc * 32 + 8 * fq;
#pragma unroll
        for (int ai = 0; ai < 2; ++ai)
#pragma unroll
            for (int m = 0; m < 4; ++m) { bf16_t* rowp = O + (size_t)(row0 + ai * HALF + m * 16) * ldc + col0;
#pragma unroll
                for (int bj = 0; bj < 2; ++bj) { f32x4 v0 = acc[ai][bj][m][0], v1 = acc[ai][bj][m][1];
                    if (ACT == 2) {
#pragma unroll
                        for (int e = 0; e < 4; ++e) { const float a = fmaxf(v0[e], 0.f), b = fmaxf(v1[e], 0.f); v0[e] = a * a; v1[e] = b * b; } }
                    u32x4 w; w.x = cvtpk(v0[0], v0[1]); w.y = cvtpk(v0[2], v0[3]); w.z = cvtpk(v1[0], v1[1]); w.w = cvtpk(v1[2], v1[3]);
                    *(u32x4*)(rowp + bj * HALF) = w; } }
    }
};
struct EpiResGate {
    static constexpr bool PERM = false;
    const float* base; float* out; const float* mod_ls; const float* colscale;
    __device__ __forceinline__ void operator()(const f32x4 (&acc)[2][2][4][2], const Unit& u, int wr, int wc, int fr, int fq) const {
        const int b = u.pm >> 5;
        const float* gate = mod_ls + (size_t)b * 3072 + 2048;
        const int col0 = u.pn * BM + wc * 32 + 4 * fq;
        f32x4 gv[2][2];
#pragma unroll
        for (int bj = 0; bj < 2; ++bj)
#pragma unroll
            for (int n = 0; n < 2; ++n) { gv[bj][n] = *(const f32x4*)(gate + col0 + bj * HALF + n * 16); if (colscale) gv[bj][n] = gv[bj][n] * *(const f32x4*)(colscale + col0 + bj * HALF + n * 16); }
#pragma unroll
        for (int ai = 0; ai < 2; ++ai)
#pragma unroll
            for (int m = 0; m < 4; ++m) { const size_t off = (size_t)(u.pm * BM + ai * HALF + wr * 64 + m * 16 + fr) * DM + col0;
#pragma unroll
                for (int bj = 0; bj < 2; ++bj)
#pragma unroll
                    for (int n = 0; n < 2; ++n) { const f32x4 bs = *(const f32x4*)(base + off + bj * HALF + n * 16); *(f32x4*)(out + off + bj * HALF + n * 16) = bs + gv[bj][n] * acc[ai][bj][m][n]; } }
    }
};

template <class Epi, bool ALIGN_EPI, bool SP2>
__device__ __forceinline__ void gemm_phase(LAS unsigned char* lds, const Gemm g, const StaticOrder& S, const Epi& E) {
    const int tid = threadIdx.x, wid = __builtin_amdgcn_readfirstlane(tid >> 6), lane = tid & 63, wr = wid >> 2, wc = wid & 3, fr = lane & 15, fq = lane >> 4;
    const int K = g.K, nt = K / BK;
    unsigned voffA[2], voffB[2];
#pragma unroll
    for (int i = 0; i < 2; ++i) { int R, C; stage_rc(tid * 16 + i * 8192, R, C); const int Rb = Epi::PERM ? ((R & ~31) + perm32(R & 31)) : R;
        voffA[i] = (unsigned)(R * g.lda + C) * 2u; voffB[i] = (unsigned)(Rb * g.ldb + C) * 2u; }
    const size_t kstep = (size_t)(BK * 2);
    const size_t hstepA = (size_t)HALF * g.lda * 2, hstepB = (size_t)HALF * g.ldb * 2;
    const size_t tstepA = 2 * hstepA, tstepB = 2 * hstepB;
    const unsigned ldsw = (unsigned)wid * 1024u;
    const int aoff = lds_byte(wr * 64 + fr, fq * 8), boff = lds_byte(wc * 32 + fr, fq * 8);
#define PG8_SA(b, h) (((b) * 2 + (h)) * HTB)
#define PG8_SB(b, h) ((4 + (b) * 2 + (h)) * HTB)
#define PG8_STAGE(bufoff, gbase, voff) do { _Pragma("unroll") for (int _i = 0; _i < 2; ++_i) \
        __builtin_amdgcn_global_load_lds((const unsigned*)((const char*)(gbase) + (voff)[_i]), (LAS unsigned*)(lds + (bufoff) + ldsw + _i * 8192), 16, 0, 0); } while (0)
#define PG8_LDA(dst, b, h) do { _Pragma("unroll") for (int m = 0; m < 4; ++m) _Pragma("unroll") for (int k = 0; k < 2; ++k) dst[m][k] = *(const LAS bf16x8*)(lds + PG8_SA(b, h) + aoff + m * 2048 + k * 1024); } while (0)
#define PG8_LDB(dst, b, h) do { _Pragma("unroll") for (int n = 0; n < 2; ++n) _Pragma("unroll") for (int k = 0; k < 2; ++k) dst[n][k] = *(const LAS bf16x8*)(lds + PG8_SB(b, h) + boff + n * 2048 + k * 1024); } while (0)
#define PG8_MMA(ai, bj, At, Bt) do { __builtin_amdgcn_s_setprio(1); _Pragma("unroll") for (int m = 0; m < 4; ++m) _Pragma("unroll") for (int n = 0; n < 2; ++n) _Pragma("unroll") for (int k = 0; k < 2; ++k) \
        acc[ai][bj][m][n] = __builtin_amdgcn_mfma_f32_16x16x32_bf16(Bt[n][k], At[m][k], acc[ai][bj][m][n], 0, 0, 0); __builtin_amdgcn_s_setprio(0); } while (0)
#define PG8_WAIT_V(n) asm volatile("s_waitcnt vmcnt(" #n ")" ::: "memory")
#define PG8_WAIT_L(n) asm volatile("s_waitcnt lgkmcnt(" #n ")" ::: "memory")
#define PG8_BAR __builtin_amdgcn_s_barrier()
#define PG8_SCHED __builtin_amdgcn_sched_barrier(0)
    Unit cur, nxt; int ui = 0;
    if (!S.next(0, cur)) return;
    f32x4 acc[2][2][4][2];
#pragma unroll
    for (int a = 0; a < 2; ++a)
#pragma unroll
        for (int b = 0; b < 2; ++b)
#pragma unroll
            for (int m = 0; m < 4; ++m)
#pragma unroll
                for (int n = 0; n < 2; ++n) acc[a][b][m][n] = (f32x4){0.f, 0.f, 0.f, 0.f};
    bf16x8 At[4][2], B0[2][2], B1[2][2];
    const char* cA = (const char*)g.A + (size_t)cur.pm * tstepA + (size_t)cur.pn * g.a_pn_koff * 2; const char* cB = (const char*)g.Bt + (size_t)cur.pn * tstepB;
    if constexpr (SP2) {
        PG8_STAGE(PG8_SB(0, 0), cB, voffB); PG8_STAGE(PG8_SB(0, 1), cB + hstepB, voffB); PG8_STAGE(PG8_SA(0, 0), cA, voffA); PG8_STAGE(PG8_SA(0, 1), cA + hstepA, voffA);
        if (wr == 1) PG8_BAR;
        PG8_WAIT_V(2); PG8_BAR;
        PG8_STAGE(PG8_SB(1, 0), cB + kstep, voffB); PG8_STAGE(PG8_SA(1, 0), cA + kstep, voffA); PG8_STAGE(PG8_SB(1, 1), cB + hstepB + kstep, voffB);
        PG8_WAIT_V(6); PG8_BAR;
    } else {
        PG8_STAGE(PG8_SB(0, 0), cB, voffB); PG8_STAGE(PG8_SA(0, 0), cA, voffA); PG8_STAGE(PG8_SB(0, 1), cB + hstepB, voffB); PG8_STAGE(PG8_SA(0, 1), cA + hstepA, voffA);
        if (wr == 1) PG8_BAR;
        PG8_WAIT_V(4); PG8_BAR;
        PG8_STAGE(PG8_SB(1, 0), cB + kstep, voffB); PG8_STAGE(PG8_SA(1, 0), cA + kstep, voffA); PG8_STAGE(PG8_SB(1, 1), cB + hstepB + kstep, voffB);
        PG8_WAIT_V(6); PG8_BAR;
    }
    for (;;) {
        const bool has_next = S.next(ui + 1, nxt);
        const char* nA = has_next ? (const char*)g.A + (size_t)nxt.pm * tstepA + (size_t)nxt.pn * g.a_pn_koff * 2 : cA; const char* nB = has_next ? (const char*)g.Bt + (size_t)nxt.pn * tstepB : cB;
        for (int t = 0; t < nt; t += 2) {
            const bool last = (t == nt - 2);
            const char* a1 = cA + (size_t)(t + 1) * kstep;
            const char* a2 = last ? nA : cA + (size_t)(t + 2) * kstep; const char* b2 = last ? nB : cB + (size_t)(t + 2) * kstep;
            const char* a3 = a2 + kstep; const char* b3 = b2 + kstep;
            if constexpr (SP2) {
            PG8_LDB(B0, 0, 0); PG8_LDB(B1, 0, 1); PG8_SCHED; PG8_LDA(At, 0, 0); PG8_STAGE(PG8_SA(1, 1), a1 + hstepA, voffA);
            PG8_WAIT_V(8); PG8_WAIT_L(0); PG8_BAR; PG8_MMA(0, 0, At, B0); PG8_MMA(0, 1, At, B1); PG8_BAR; PG8_SCHED;
            PG8_LDA(At, 0, 1); PG8_STAGE(PG8_SB(0, 0), b2, voffB); PG8_STAGE(PG8_SB(0, 1), b2 + hstepB, voffB); PG8_STAGE(PG8_SA(0, 0), a2, voffA);
            PG8_WAIT_V(8); PG8_WAIT_L(0); PG8_BAR; PG8_MMA(1, 0, At, B0); PG8_MMA(1, 1, At, B1); PG8_BAR; PG8_SCHED;
            PG8_LDB(B0, 1, 0); PG8_LDB(B1, 1, 1); PG8_SCHED; PG8_LDA(At, 1, 0); PG8_STAGE(PG8_SA(0, 1), a2 + hstepA, voffA);
            PG8_WAIT_V(8); PG8_WAIT_L(0); PG8_BAR; PG8_MMA(0, 0, At, B0); PG8_MMA(0, 1, At, B1); PG8_BAR; PG8_SCHED;
            PG8_LDA(At, 1, 1); PG8_STAGE(PG8_SB(1, 0), b3, voffB); PG8_STAGE(PG8_SB(1, 1), b3 + hstepB, voffB); PG8_STAGE(PG8_SA(1, 0), a3, voffA);
            PG8_WAIT_V(8); PG8_WAIT_L(0); PG8_BAR; PG8_MMA(1, 0, At, B0); PG8_MMA(1, 1, At, B1); PG8_BAR; PG8_SCHED;
            } else {
            PG8_LDB(B0, 0, 0); PG8_SCHED; PG8_LDA(At, 0, 0); PG8_STAGE(PG8_SA(1, 1), a1 + hstepA, voffA);
            PG8_WAIT_L(8); PG8_BAR; PG8_WAIT_L(0); PG8_MMA(0, 0, At, B0); PG8_BAR; PG8_SCHED;
            PG8_LDB(B1, 0, 1); PG8_STAGE(PG8_SB(0, 0), b2, voffB);
            PG8_BAR; PG8_WAIT_L(0); PG8_MMA(0, 1, At, B1); PG8_BAR;
            PG8_LDA(At, 0, 1); PG8_STAGE(PG8_SA(0, 0), a2, voffA);
            PG8_BAR; PG8_WAIT_L(0); PG8_MMA(1, 0, At, B0); PG8_BAR; PG8_SCHED;
            PG8_STAGE(PG8_SB(0, 1), b2 + hstepB, voffB);
            PG8_WAIT_V(6); PG8_BAR; PG8_MMA(1, 1, At, B1); PG8_BAR;
            PG8_LDB(B0, 1, 0); PG8_SCHED; PG8_LDA(At, 1, 0); PG8_STAGE(PG8_SA(0, 1), a2 + hstepA, voffA);
            PG8_WAIT_L(8); PG8_BAR; PG8_WAIT_L(0); PG8_MMA(0, 0, At, B0); PG8_BAR; PG8_SCHED;
            PG8_LDB(B1, 1, 1); PG8_STAGE(PG8_SB(1, 0), b3, voffB);
            PG8_BAR; PG8_WAIT_L(0); PG8_MMA(0, 1, At, B1); PG8_BAR;
            PG8_LDA(At, 1, 1); PG8_STAGE(PG8_SA(1, 0), a3, voffA);
            PG8_BAR; PG8_WAIT_L(0); PG8_MMA(1, 0, At, B0); PG8_BAR; PG8_SCHED;
            PG8_STAGE(PG8_SB(1, 1), b3 + hstepB, voffB);
            PG8_WAIT_V(6); PG8_BAR; PG8_MMA(1, 1, At, B1); PG8_BAR;
            }
        }
        if constexpr (ALIGN_EPI) { if (wr == 0) PG8_BAR; }
        E(acc, cur, wr, wc, fr, fq);
        if (!has_next) break;
#pragma unroll
        for (int a = 0; a < 2; ++a)
#pragma unroll
            for (int b = 0; b < 2; ++b)
#pragma unroll
                for (int m = 0; m < 4; ++m)
#pragma unroll
                    for (int n = 0; n < 2; ++n) acc[a][b][m][n] = (f32x4){0.f, 0.f, 0.f, 0.f};
        cur = nxt; cA = nA; cB = nB; ++ui;
        if constexpr (ALIGN_EPI) { if (wr == 1) PG8_BAR; }
    }
    PG8_WAIT_V(0);
    if constexpr (!ALIGN_EPI) { if (wr == 0) PG8_BAR; }
    PG8_BAR;
#undef PG8_SA
#undef PG8_SB
#undef PG8_STAGE
#undef PG8_LDA
#undef PG8_LDB
#undef PG8_MMA
#undef PG8_WAIT_V
#undef PG8_WAIT_L
#undef PG8_BAR
#undef PG8_SCHED
}
}

#define XB_TMO      128
#define XB_XCNT(j)  (256  + 64 * (j))
#define XB_XSUB(j)  (1280 + 64 * (j))
#define XB_XGEN(j)  (2304 + 64 * (j))
#define XB_TOP      3328
#define XB_TOPGEN   3392
#define XCD_BAR_WORDS 3456
#define XB_SPIN_CAP (1u << 18)
DI unsigned xb_ld(unsigned* p)              { return __hip_atomic_load(p, __ATOMIC_RELAXED, __HIP_MEMORY_SCOPE_AGENT); }
DI unsigned xb_add(unsigned* p, unsigned v) { return __hip_atomic_fetch_add(p, v, __ATOMIC_RELAXED, __HIP_MEMORY_SCOPE_AGENT); }
DI unsigned xb_xcc_id() { return (unsigned)__builtin_amdgcn_s_getreg((3 << 11) | 20) & 0xFu; }
#define XB_SPIN(cond, bar) do { unsigned _sp = 0; while (cond) { __builtin_amdgcn_s_sleep(1); \
    if ((++_sp & 255u) == 0u) { if (xb_ld(&(bar)[XB_TMO])) break; if (_sp > XB_SPIN_CAP) { atomicAdd(&(bar)[XB_TMO], 1u); break; } } } } while (0)
struct XcdBarrier { unsigned* bar; unsigned x; volatile LAS unsigned* st; };
DI XcdBarrier xcd_barrier_post(unsigned* bar, volatile LAS unsigned* st) {
    XcdBarrier b; b.bar = bar; b.x = xb_xcc_id(); b.st = st;
    if (threadIdx.x == 0) (void)xb_add(&bar[XB_XCNT(b.x)], 1u);
    return b;
}
DI void xcd_barrier_complete(unsigned* bar, unsigned x, unsigned& nloc, unsigned& nx) {
    const unsigned G = gridDim.x * gridDim.y * gridDim.z;
    unsigned sum, cnt, mine, sp = 0u;
    for (;;) {
        sum = 0u; cnt = 0u; mine = 0u;
#pragma unroll
        for (unsigned j = 0; j < 16; ++j) { const unsigned c = xb_ld(&bar[XB_XCNT(j)]); sum += c; cnt += (c > 0u) ? 1u : 0u; mine = (j == x) ? c : mine; }
        if (sum == G) break;
        __builtin_amdgcn_s_sleep(1);
        if ((++sp & 255u) == 0u) { if (xb_ld(&bar[XB_TMO])) break; if (sp > XB_SPIN_CAP) { atomicAdd(&bar[XB_TMO], 1u); break; } }
    }
    nloc = mine > 0u ? mine : 1u; nx = cnt > 0u ? cnt : 1u;
}
DI void xcd_barrier(const XcdBarrier& b) {
    asm volatile("s_waitcnt vmcnt(0)" ::: "memory");
    __syncthreads();
    if (threadIdx.x == 0) {
        unsigned* bar = b.bar;
        __builtin_amdgcn_s_waitcnt(0);
        unsigned nloc = b.st[0], nx = b.st[1];
        if (nloc == 0u) { xcd_barrier_complete(bar, b.x, nloc, nx); b.st[0] = nloc; b.st[1] = nx; }
        const unsigned old = xb_add(&bar[XB_XSUB(b.x)], 1u);
        const unsigned gen = old / nloc;
        if (old + 1u == (gen + 1u) * nloc) {
            __builtin_amdgcn_fence(__ATOMIC_RELEASE, "agent");
            asm volatile("s_waitcnt vmcnt(0)" ::: "memory");
            const unsigned og = xb_add(&bar[XB_TOP], 1u);
            const unsigned tg = og / nx;
            if (og + 1u == (tg + 1u) * nx) xb_add(&bar[XB_TOPGEN], 1u);
            else XB_SPIN(xb_ld(&bar[XB_TOPGEN]) == tg, bar);
            __builtin_amdgcn_fence(__ATOMIC_ACQUIRE, "agent");
            xb_add(&bar[XB_XGEN(b.x)], 1u);
            asm volatile("s_waitcnt vmcnt(0)" ::: "memory");
        } else {
            XB_SPIN(xb_ld(&bar[XB_XGEN(b.x)]) == gen, bar);
            __builtin_amdgcn_fence(__ATOMIC_ACQUIRE, "agent");
            asm volatile("s_waitcnt vmcnt(0)" ::: "memory");
        }
    }
    __syncthreads();
}

DI void p0_mod_unit(int unit, const float* c, const float* ada_w, const float* ada_b, float* MOD, LAS unsigned char* lds, int tid, int wave, int lane) {
    LAS float* sc = (LAS float*)lds;
    LAS float* red = (LAS float*)(lds + 16384);
    const int ls = unit / 48, j0 = (unit % 48) * 64;
    for (int k = tid; k < 1024; k += NTHR) {
#pragma unroll
        for (int b = 0; b < 4; ++b) sc[k * 4 + b] = silu_f(c[b * 1024 + k]);
    }
    __syncthreads();
    const float* w = ada_w + (size_t)ls * 1024 * 3072 + (size_t)(wave * 128) * 3072 + j0 + lane;
    float a0 = 0.f, a1 = 0.f, a2 = 0.f, a3 = 0.f;
#pragma unroll 8
    for (int k = 0; k < 128; ++k) { const float wv = w[(size_t)k * 3072]; const f32x4 s = *(const LAS f32x4*)(sc + (wave * 128 + k) * 4);
        a0 += wv * s[0]; a1 += wv * s[1]; a2 += wv * s[2]; a3 += wv * s[3]; }
    red[(wave * 4 + 0) * 64 + lane] = a0; red[(wave * 4 + 1) * 64 + lane] = a1; red[(wave * 4 + 2) * 64 + lane] = a2; red[(wave * 4 + 3) * 64 + lane] = a3;
    __syncthreads();
    if (wave < 4) { float s = ada_b[ls * 3072 + j0 + lane];
#pragma unroll
        for (int w8 = 0; w8 < 8; ++w8) s += red[(w8 * 4 + wave) * 64 + lane];
        MOD[((size_t)ls * 4 + wave) * 3072 + j0 + lane] = s; }
    __syncthreads();
}
DI void p0_transpose_item(const float* W, int ldw, int src_col0, bf16_t* WT, int K, int dst_row0, int k0, LAS float* scr, int lane) {
#pragma unroll 8
    for (int i = 0; i < 32; ++i) { const int kk = 2 * i + (lane >> 5); scr[kk * 33 + (lane & 31)] = W[(size_t)(k0 + kk) * ldw + src_col0 + (lane & 31)]; }
    asm volatile("s_waitcnt lgkmcnt(0)" ::: "memory");
    const int c = lane & 7;
#pragma unroll
    for (int j = 0; j < 4; ++j) { const int n = (lane >> 3) + 8 * j; const LAS float* s = scr + (8 * c) * 33 + n;
        u32x4 o; o.x = cvtpk(s[0 * 33], s[1 * 33]); o.y = cvtpk(s[2 * 33], s[3 * 33]); o.z = cvtpk(s[4 * 33], s[5 * 33]); o.w = cvtpk(s[6 * 33], s[7 * 33]);
        *(u32x4*)(WT + (size_t)(dst_row0 + n) * K + k0 + 8 * c) = o; }
    asm volatile("s_waitcnt lgkmcnt(0)" ::: "memory");
}
DI void p0_gatefold_item(const float* Win, const float* wgate, bf16_t* WT, int n0, int k0, LAS float* scr, int lane) {
    const int nn = lane & 31;
    float wg[16];
#pragma unroll
    for (int r = 0; r < 16; ++r) wg[r] = wgate[r * 256 + n0 + nn];
    for (int i = 0; i < 32; ++i) { const int kk = 2 * i + (lane >> 5); const float* src = Win + (size_t)(k0 + kk) * INCOLS + 1536; float s = 0.f;
#pragma unroll
        for (int r = 0; r < 16; ++r) s += src[r] * wg[r];
        scr[kk * 33 + nn] = s; }
    asm volatile("s_waitcnt lgkmcnt(0)" ::: "memory");
    const int c = lane & 7;
#pragma unroll
    for (int j = 0; j < 4; ++j) { const int n = (lane >> 3) + 8 * j; const LAS float* s = scr + (8 * c) * 33 + n;
        u32x4 o; o.x = cvtpk(s[0 * 33], s[1 * 33]); o.y = cvtpk(s[2 * 33], s[3 * 33]); o.z = cvtpk(s[4 * 33], s[5 * 33]); o.w = cvtpk(s[6 * 33], s[7 * 33]);
        *(u32x4*)(WT + (size_t)(PC_GL + n0 + n) * 1024 + k0 + 8 * c) = o; }
    asm volatile("s_waitcnt lgkmcnt(0)" ::: "memory");
}
DI void norm_rows(const float* X, bf16_t* Hout, const float* nw, const float* mod_ls, int gw, int NGW, int lane) {
    for (int m = gw; m < MTOK; m += NGW) {
        const int b = m >> 13;
        const f32x4* xr = (const f32x4*)(X + (size_t)m * DM) + lane;
        const f32x4* nwp = (const f32x4*)nw + lane; const f32x4* shp = (const f32x4*)(mod_ls + (size_t)b * 3072) + lane; const f32x4* scp = (const f32x4*)(mod_ls + (size_t)b * 3072 + 1024) + lane;
        f32x4 v[4]; float s = 0.f;
#pragma unroll
        for (int j = 0; j < 4; ++j) { v[j] = xr[64 * j]; s += (v[j].x * v[j].x + v[j].y * v[j].y) + (v[j].z * v[j].z + v[j].w * v[j].w); }
        const float rstd = rsqrtf(wave_sum(s) * (1.f / DM) + EPS);
        u32x2* o8 = (u32x2*)(Hout + (size_t)m * DM) + lane;
#pragma unroll
        for (int j = 0; j < 4; ++j) { const f32x4 g = nwp[64 * j] * (scp[64 * j] + 1.0f), sh = shp[64 * j]; const f32x4 h = v[j] * rstd * g + sh;
            u32x2 w; w.x = cvtpk(h.x, h.y); w.y = cvtpk(h.z, h.w); o8[64 * j] = w; }
    }
}
DI void final_norm_rows(float* X, const float* fw, int gw, int NGW, int lane) {
    for (int m = gw; m < MTOK; m += NGW) {
        f32x4* xr = (f32x4*)(X + (size_t)m * DM) + lane; const f32x4* fwp = (const f32x4*)fw + lane;
        f32x4 v[4]; float s = 0.f;
#pragma unroll
        for (int j = 0; j < 4; ++j) { v[j] = xr[64 * j]; s += (v[j].x * v[j].x + v[j].y * v[j].y) + (v[j].z * v[j].z + v[j].w * v[j].w); }
        const float rstd = rsqrtf(wave_sum(s) * (1.f / DM) + EPS);
#pragma unroll
        for (int j = 0; j < 4; ++j) xr[64 * j] = v[j] * rstd * fwp[64 * j];
    }
}
DI void gla_naive_rec(int wg, const bf16_t* PROJ, const float* bgate, float* OG, int tid) {
    const int b = wg >> 2, h = wg & 3, e = tid >> 2, dq = tid & 3;
    float S[16], bg[16];
#pragma unroll
    for (int i = 0; i < 16; ++i) bg[i] = bgate[h * 64 + 16 * dq + i];
#pragma unroll
    for (int i = 0; i < 16; ++i) S[i] = 0.f;
    const bf16_t* row = PROJ + (size_t)(b * SEQ) * NPROJ;
    for (int t = 0; t < SEQ; ++t, row += NPROJ) {
        const u32x4* lgp = (const u32x4*)(row + PC_GL + h * 64 + 16 * dq); const u32x4* kp = (const u32x4*)(row + PC_GK + h * 64 + 16 * dq); const u32x4* qp = (const u32x4*)(row + PC_GQ + h * 64 + 16 * dq);
        const u32x4 l0 = lgp[0], l1 = lgp[1], k0 = kp[0], k1 = kp[1], q0 = qp[0], q1 = qp[1];
        const float v = bf2f(row[PC_GV + h * 128 + e]);
        float lg[16], kk[16], qq[16];
#pragma unroll
        for (int i = 0; i < 4; ++i) { lg[2 * i] = bflo(l0[i]); lg[2 * i + 1] = bfhi(l0[i]); lg[8 + 2 * i] = bflo(l1[i]); lg[8 + 2 * i + 1] = bfhi(l1[i]);
            kk[2 * i] = bflo(k0[i]); kk[2 * i + 1] = bfhi(k0[i]); kk[8 + 2 * i] = bflo(k1[i]); kk[8 + 2 * i + 1] = bfhi(k1[i]);
            qq[2 * i] = bflo(q0[i]); qq[2 * i + 1] = bfhi(q0[i]); qq[8 + 2 * i] = bflo(q1[i]); qq[8 + 2 * i + 1] = bfhi(q1[i]); }
        float o = 0.f;
#pragma unroll
        for (int i = 0; i < 16; ++i) { const float a = __expf(logsigmoid_f(lg[i] + bg[i]) * (1.f / 16.f)); S[i] = a * S[i] + kk[i] * v; o += qq[i] * S[i]; }
        o += __shfl_xor(o, 1); o += __shfl_xor(o, 2);
        if (dq == 0) OG[(size_t)(b * SEQ + t) * 512 + h * 128 + e] = o * 0.125f;
    }
}
DI void gla_norm_gate(const float* OG, const bf16_t* PROJ, const float* gnw, bf16_t* MIX, int gw, int NGW, int lane) {
    const f32x2 g = *((const f32x2*)gnw + lane);
    for (int it = gw; it < MTOK * 4; it += NGW) {
        const int tok = it >> 2, h = it & 3;
        const f32x2 o = *((const f32x2*)(OG + (size_t)tok * 512 + h * 128) + lane);
        const float rstd = rsqrtf(wave_sum(o.x * o.x + o.y * o.y) * (1.f / 128.f) + EPS);
        const unsigned gg = *((const unsigned*)(PROJ + (size_t)tok * NPROJ + PC_GG + h * 128) + lane);
        const float y0 = o.x * rstd * g.x * silu_f(bflo(gg)), y1 = o.y * rstd * g.y * silu_f(bfhi(gg));
        *((unsigned*)(MIX + (size_t)tok * DM + h * 128) + lane) = cvtpk(y0, y1);
    }
}
DI void swa_naive(long gid, const bf16_t* PROJ, const float* rel_bias, const float* sinks, bf16_t* MIX) {
    const int t = (int)(gid & (SEQ - 1)), head = (int)((gid >> 13) & 7), b = (int)(gid >> 16), kvh = head >> 2;
    const bf16_t* base = PROJ + (size_t)(b * SEQ) * NPROJ;
    float q[64], o[64];
    { const u32x4* qp = (const u32x4*)(base + (size_t)t * NPROJ + PC_SQ + head * 64);
#pragma unroll
      for (int i = 0; i < 8; ++i) { const u32x4 w = qp[i];
#pragma unroll
          for (int j = 0; j < 4; ++j) { q[8 * i + 2 * j] = bflo(w[j]) * 0.125f; q[8 * i + 2 * j + 1] = bfhi(w[j]) * 0.125f; } } }
#pragma unroll
    for (int i = 0; i < 64; ++i) o[i] = 0.f;
    float m = sinks[head], l = 1.f;
    for (int dist = 127; dist >= 0; --dist) {
        const int tk = t - dist; if (tk < 0) continue;
        const u32x4* kp = (const u32x4*)(base + (size_t)tk * NPROJ + PC_SK + kvh * 64); const u32x4* vp = (const u32x4*)(base + (size_t)tk * NPROJ + PC_SV + kvh * 64);
        float s = 0.f;
#pragma unroll
        for (int i = 0; i < 8; ++i) { const u32x4 w = kp[i];
#pragma unroll
            for (int j = 0; j < 4; ++j) { s += q[8 * i + 2 * j] * bflo(w[j]); s += q[8 * i + 2 * j + 1] * bfhi(w[j]); } }
        s += rel_bias[T5B[dist] * 8 + head];
        const float mn = fmaxf(m, s), alpha = __expf(m - mn), p = __expf(s - mn);
        l = l * alpha + p; m = mn;
#pragma unroll
        for (int i = 0; i < 8; ++i) { const u32x4 w = vp[i];
#pragma unroll
            for (int j = 0; j < 4; ++j) { o[8 * i + 2 * j] = o[8 * i + 2 * j] * alpha + p * bflo(w[j]); o[8 * i + 2 * j + 1] = o[8 * i + 2 * j + 1] * alpha + p * bfhi(w[j]); } }
    }
    const float rl = 1.f / l;
    u32x4* op = (u32x4*)(MIX + (size_t)(b * SEQ + t) * DM + 512 + head * 64);
#pragma unroll
    for (int i = 0; i < 8; ++i) { u32x4 w;
#pragma unroll
        for (int j = 0; j < 4; ++j) w[j] = cvtpk(o[8 * i + 2 * j] * rl, o[8 * i + 2 * j + 1] * rl);
        op[i] = w; }
}
DI void pool_tile(int tile, const float* X, bf16_t* POOL, const float* nw, const float* mod_ls, LAS unsigned char* lds, int tid, int wave, int lane) {
    LAS float* rs = (LAS float*)lds;
    const int b = tile >> 6, t0 = (tile & 63) * 128;
    for (int ri = wave; ri < 143; ri += NWAVES) { const int t = t0 - 15 + ri; if (t < 0) continue;
        const f32x4* xr = (const f32x4*)(X + (size_t)(b * SEQ + t) * DM) + lane; float s = 0.f;
#pragma unroll
        for (int j = 0; j < 4; ++j) { const f32x4 v = xr[64 * j]; s += (v.x * v.x + v.y * v.y) + (v.z * v.z + v.w * v.w); }
        s = wave_sum(s); if (lane == 0) rs[ri] = rsqrtf(s * (1.f / DM) + EPS); }
    __syncthreads();
    const int c0 = 2 * tid, w = 2 << (wave >> 1);
    const f32x2 g = *(const f32x2*)(nw + c0) * (*(const f32x2*)(mod_ls + (size_t)b * 3072 + 1024 + c0) + 1.0f), sh = *(const f32x2*)(mod_ls + (size_t)b * 3072 + c0);
    f32x2 ring[16];
#pragma unroll
    for (int i = 0; i < 16; ++i) ring[i] = (f32x2){0.f, 0.f};
    for (int base = 0; base < 144; base += 16) {
#pragma unroll
        for (int u = 0; u < 16; ++u) { const int ri = base + u, t = t0 - 15 + ri;
            f32x2 val = (f32x2){0.f, 0.f};
            if (ri < 143 && t >= 0) { const f32x2 x = *(const f32x2*)(X + (size_t)(b * SEQ + t) * DM + c0); val = x * rs[ri] * g + sh; }
            ring[u] = val;
            if (ri >= 15 && ri < 143) { f32x2 sum = (f32x2){0.f, 0.f};
#pragma unroll
                for (int j = 0; j < 16; ++j) if (j < w) sum += ring[(u - j) & 15];
                const float cnt = (float)((t + 1 < w) ? t + 1 : w); const f32x2 p = sum * (1.f / cnt) - val;
                *(unsigned*)(POOL + (size_t)(b * SEQ + t) * DM + c0) = cvtpk(p.x, p.y); }
        }
    }
    __syncthreads();
}


#define MFMA32(a, b, c) __builtin_amdgcn_mfma_f32_32x32x16_bf16((a), (b), (c), 0, 0, 0)
DI int crow(int reg, int hi) { return (reg & 3) + 8 * (reg >> 2) + 4 * hi; }
DI unsigned short f2bf1(float f) { return (unsigned short)(cvtpk(f, 0.f) & 0xffffu); }
#define LDS_FENCE() asm volatile("s_waitcnt lgkmcnt(0)" ::: "memory")

DI void gla_g1_item(int it, const bf16_t* PROJ, const float* bgate, float* DS, float* DEC, LAS unsigned char* wl, int lane) {
    const int h = it & 3, n = (it >> 2) & 127, b = it >> 9, r = lane & 31, hi = lane >> 5;
    const bf16_t* base = PROJ + ((size_t)b * SEQ + (size_t)n * 64) * NPROJ;
    LAS unsigned char* ke = wl; LAS unsigned char* vt = wl + 9216;
    {
        const float bg = bgate[h * 64 + lane];
        const bf16_t* lgp = base + PC_GL + h * 64 + lane; const bf16_t* kp = base + PC_GK + h * 64 + lane;
        float bc[64]; float run = 0.f;
#pragma unroll
        for (int i = 0; i < 64; ++i) { run += logsigmoid_f(bf2f(lgp[(size_t)i * NPROJ]) + bg) * (1.f / 16.f); bc[i] = run; }
        DEC[(size_t)it * 64 + lane] = __expf(run);
#pragma unroll
        for (int i8 = 0; i8 < 8; ++i8) { u32x4 w;
#pragma unroll
            for (int jj = 0; jj < 4; ++jj) { const int i = 8 * i8 + 2 * jj;
                const float k0 = bf2f(kp[(size_t)i * NPROJ]) * __expf(run - bc[i]), k1 = bf2f(kp[(size_t)(i + 1) * NPROJ]) * __expf(run - bc[i + 1]); w[jj] = cvtpk(k0, k1); }
            *(LAS u32x4*)(ke + lane * 144 + i8 * 16) = w; }
    }
    float* dsb = DS + (size_t)it * 8192;
#pragma unroll 1
    for (int eh = 0; eh < 2; ++eh) {
        LDS_FENCE();
        const bf16_t* vp = base + PC_GV + h * 128 + eh * 64 + lane;
#pragma unroll
        for (int j8 = 0; j8 < 8; ++j8) { u32x4 w;
#pragma unroll
            for (int jj = 0; jj < 4; ++jj) { const int j = 8 * j8 + 2 * jj; w[jj] = (unsigned)vp[(size_t)j * NPROJ] | ((unsigned)vp[(size_t)(j + 1) * NPROJ] << 16); }
            *(LAS u32x4*)(vt + lane * 144 + j8 * 16) = w; }
        LDS_FENCE();
        f32x16 acc[2][2];
#pragma unroll
        for (int et = 0; et < 2; ++et)
#pragma unroll
            for (int dt = 0; dt < 2; ++dt)
#pragma unroll
                for (int q = 0; q < 16; ++q) acc[et][dt][q] = 0.f;
#pragma unroll
        for (int s = 0; s < 4; ++s) { bf16x8 a[2], bb[2];
#pragma unroll
            for (int t = 0; t < 2; ++t) { a[t] = *(const LAS bf16x8*)(vt + (32 * t + r) * 144 + (16 * s + 8 * hi) * 2); bb[t] = *(const LAS bf16x8*)(ke + (32 * t + r) * 144 + (16 * s + 8 * hi) * 2); }
#pragma unroll
            for (int et = 0; et < 2; ++et)
#pragma unroll
                for (int dt = 0; dt < 2; ++dt) acc[et][dt] = MFMA32(a[et], bb[dt], acc[et][dt]); }
#pragma unroll
        for (int et = 0; et < 2; ++et)
#pragma unroll
            for (int dt = 0; dt < 2; ++dt)
#pragma unroll
                for (int q = 0; q < 16; ++q) dsb[(size_t)(eh * 64 + 32 * et + crow(q, hi)) * 64 + 32 * dt + r] = acc[et][dt][q];
    }
    LDS_FENCE();
}
DI void gla_scan(float* DS, const float* DEC, int bx, int G, int tid) {
    for (int idx = bx * NTHR + tid; idx < NB * 4 * 128 * 64; idx += G * NTHR) {
        const int d = idx & 63, e = (idx >> 6) & 127, h = (idx >> 13) & 3, b = idx >> 15;
        float* p = DS + ((size_t)(b * 128) * 4 + h) * 8192 + e * 64 + d; const float* dp = DEC + ((size_t)(b * 128) * 4 + h) * 64 + d;
        float s = 0.f;
#pragma unroll 1
        for (int n0 = 0; n0 < 128; n0 += 16) { float ds[16], dc[16];
#pragma unroll
            for (int u = 0; u < 16; ++u) { ds[u] = p[(size_t)(n0 + u) * 32768]; dc[u] = dp[(size_t)(n0 + u) * 256]; }
#pragma unroll
            for (int u = 0; u < 16; ++u) { p[(size_t)(n0 + u) * 32768] = s; s = dc[u] * s + ds[u]; } }
    }
}
constexpr int G3_QT = 0, G3_KT = 9216, G3_VT = 18432, G3_SS = 36864, G3_ST = 46080, G3_SEG = 64512, G3_PART = 65536, G3_BYTES = 77824;
DI void gla_g3_phase(const bf16_t* PROJ, const float* bgate, const float* SIN, const float* gnw, bf16_t* MIX, LAS unsigned char* lds, int bx, int G, int wave, int lane) {
    const int grp = wave >> 2, w4 = wave & 3, r = lane & 31, hi = lane >> 5;
    LAS unsigned char* gl = lds + grp * G3_BYTES;
    LAS float* SEG = (LAS float*)(gl + G3_SEG); LAS float* PART = (LAS float*)(gl + G3_PART);
    for (int rnd = 0; rnd * G * 2 < 2048; ++rnd) {
        const int item = (rnd * G + bx) * 2 + grp; const bool valid = item < 2048;
        const int h = item & 3, n = (item >> 2) & 127, b = item >> 9;
        const bf16_t* base = PROJ + ((size_t)b * SEQ + (size_t)n * 64) * NPROJ;
        const int i0 = 16 * w4;
        float la[16], qv[16], kv[16];
        if (valid) {
            const float bg = bgate[h * 64 + lane];
            const bf16_t* lgp = base + (size_t)i0 * NPROJ + PC_GL + h * 64 + lane; const bf16_t* qp = base + (size_t)i0 * NPROJ + PC_GQ + h * 64 + lane; const bf16_t* kp = base + (size_t)i0 * NPROJ + PC_GK + h * 64 + lane;
            float run = 0.f;
#pragma unroll
            for (int i = 0; i < 16; ++i) { run += logsigmoid_f(bf2f(lgp[(size_t)i * NPROJ]) + bg) * (1.f / 16.f); la[i] = run; qv[i] = bf2f(qp[(size_t)i * NPROJ]); kv[i] = bf2f(kp[(size_t)i * NPROJ]); }
            SEG[w4 * 64 + lane] = run;
            const unsigned* vp = (const unsigned*)(base + (size_t)i0 * NPROJ + PC_GV + h * 128) + lane;
            unsigned vv[16];
#pragma unroll
            for (int j = 0; j < 16; ++j) vv[j] = vp[(size_t)j * (NPROJ / 2)];
            u32x4 a0, a1, b0, b1;
#pragma unroll
            for (int jj = 0; jj < 4; ++jj) { a0[jj] = (vv[2 * jj] & 0xffffu) | (vv[2 * jj + 1] << 16); a1[jj] = (vv[8 + 2 * jj] & 0xffffu) | (vv[8 + 2 * jj + 1] << 16);
                b0[jj] = (vv[2 * jj] >> 16) | (vv[2 * jj + 1] & 0xffff0000u); b1[jj] = (vv[8 + 2 * jj] >> 16) | (vv[8 + 2 * jj + 1] & 0xffff0000u); }
            LAS unsigned char* vrow = gl + G3_VT + (2 * lane) * 144 + i0 * 2;
            *(LAS u32x4*)(vrow) = a0; *(LAS u32x4*)(vrow + 16) = a1; *(LAS u32x4*)(vrow + 144) = b0; *(LAS u32x4*)(vrow + 144 + 16) = b1;
            const float* sp = SIN + (size_t)item * 8192;
#pragma unroll
            for (int i8 = 0; i8 < 8; ++i8) { const int e = 32 * w4 + 4 * i8 + (lane >> 4), dc = 4 * (lane & 15); const f32x4 sv = *(const f32x4*)(sp + e * 64 + dc);
                u32x2 w; w.x = cvtpk(sv[0], sv[1]); w.y = cvtpk(sv[2], sv[3]); *(LAS u32x2*)(gl + G3_ST + e * 144 + dc * 2) = w; }
        }
        __syncthreads();
        if (valid) {
            float pre = 0.f;
#pragma unroll
            for (int w = 0; w < 3; ++w) if (w < w4) pre += SEG[w * 64 + lane];
#pragma unroll
            for (int i = 0; i < 16; ++i) { const float bi = pre + la[i];
                *(LAS unsigned short*)(gl + G3_QT + (i0 + i) * 144 + lane * 2) = f2bf1(qv[i] * 0.125f * __expf(bi));
                *(LAS unsigned short*)(gl + G3_KT + (i0 + i) * 144 + lane * 2) = f2bf1(kv[i] * __expf(-bi)); }
        }
        __syncthreads();
        if (valid) {
            const int jt = w4 >> 1, it = w4 & 1;
            f32x16 acc;
#pragma unroll
            for (int q = 0; q < 16; ++q) acc[q] = 0.f;
            if (!(jt == 1 && it == 0)) {
#pragma unroll
                for (int s = 0; s < 4; ++s) { const bf16x8 a = *(const LAS bf16x8*)(gl + G3_KT + (32 * jt + r) * 144 + (16 * s + 8 * hi) * 2); const bf16x8 bq = *(const LAS bf16x8*)(gl + G3_QT + (32 * it + r) * 144 + (16 * s + 8 * hi) * 2);
                    acc = MFMA32(a, bq, acc); } }
#pragma unroll
            for (int g = 0; g < 4; ++g) { float v[4];
#pragma unroll
                for (int k = 0; k < 4; ++k) { const int j = 32 * jt + 8 * g + 4 * hi + k, i = 32 * it + r; v[k] = (j <= i) ? acc[4 * g + k] : 0.f; }
                u32x2 w; w.x = cvtpk(v[0], v[1]); w.y = cvtpk(v[2], v[3]);
                *(LAS u32x2*)(gl + G3_SS + (32 * it + r) * 144 + (32 * jt + 8 * g + 4 * hi) * 2) = w; }
        }
        __syncthreads();
        f32x16 oacc[2];
        if (valid) {
#pragma unroll
            for (int it = 0; it < 2; ++it) {
#pragma unroll
                for (int q = 0; q < 16; ++q) oacc[it][q] = 0.f;
#pragma unroll
                for (int s = 0; s < 4; ++s) { if (it == 0 && s >= 2) continue;
                    const bf16x8 a = *(const LAS bf16x8*)(gl + G3_VT + (32 * w4 + r) * 144 + (16 * s + 8 * hi) * 2); const bf16x8 bs = *(const LAS bf16x8*)(gl + G3_SS + (32 * it + r) * 144 + (16 * s + 8 * hi) * 2);
                    oacc[it] = MFMA32(a, bs, oacc[it]); }
#pragma unroll
                for (int s = 0; s < 4; ++s) { const bf16x8 a = *(const LAS bf16x8*)(gl + G3_ST + (32 * w4 + r) * 144 + (16 * s + 8 * hi) * 2); const bf16x8 bq = *(const LAS bf16x8*)(gl + G3_QT + (32 * it + r) * 144 + (16 * s + 8 * hi) * 2);
                    oacc[it] = MFMA32(a, bq, oacc[it]); }
                float ss = 0.f;
#pragma unroll
                for (int q = 0; q < 16; ++q) ss += oacc[it][q] * oacc[it][q];
                ss += __shfl_xor(ss, 32);
                if (hi == 0) PART[w4 * 64 + 32 * it + r] = ss;
            }
        }
        __syncthreads();
        if (valid) {
#pragma unroll
            for (int it = 0; it < 2; ++it) { const int i = 32 * it + r;
                const float tot = (PART[i] + PART[64 + i]) + (PART[128 + i] + PART[192 + i]); const float rstd = rsqrtf(tot * (1.f / 128.f) + EPS);
                const size_t row = (size_t)b * SEQ + (size_t)n * 64 + i;
#pragma unroll
                for (int g = 0; g < 4; ++g) { const int e0 = 32 * w4 + 8 * g + 4 * hi;
                    const u32x2 gg = *(const u32x2*)(PROJ + row * NPROJ + PC_GG + h * 128 + e0); const f32x4 gw4 = *(const f32x4*)(gnw + e0);
                    const float y0 = oacc[it][4 * g + 0] * rstd * gw4[0] * silu_f(bflo(gg.x)), y1 = oacc[it][4 * g + 1] * rstd * gw4[1] * silu_f(bfhi(gg.x));
                    const float y2 = oacc[it][4 * g + 2] * rstd * gw4[2] * silu_f(bflo(gg.y)), y3 = oacc[it][4 * g + 3] * rstd * gw4[3] * silu_f(bfhi(gg.y));
                    u32x2 w; w.x = cvtpk(y0, y1); w.y = cvtpk(y2, y3); *(u32x2*)(MIX + row * DM + h * 128 + e0) = w; } }
        }
    }
    __syncthreads();
}
constexpr int SW_KS = 0, SW_VT = 36864, SW_BIAS = 70144;
DI void swa_item(int item, const bf16_t* PROJ, const float* rel_bias, const float* sinks, bf16_t* MIX, LAS unsigned char* lds, int tid, int wave, int lane) {
    const int kvh = item & 1, blk = (item >> 1) & 63, b = item >> 7, r = lane & 31, hi = lane >> 5;
    const bf16_t* pb = PROJ + (size_t)b * SEQ * NPROJ;
    LAS float* BIAS = (LAS float*)(lds + SW_BIAS);
    for (int c = tid; c < 2048; c += NTHR) { const int kj = c >> 3, ch = c & 7, trow = (blk - 1) * 128 + kj; u32x4 w = (u32x4){0u, 0u, 0u, 0u};
        if (trow >= 0) w = *(const u32x4*)(pb + (size_t)trow * NPROJ + PC_SK + kvh * 64 + ch * 8);
        *(LAS u32x4*)(lds + SW_KS + kj * 144 + ch * 16) = w; }
#pragma unroll
    for (int k4 = 0; k4 < 8; ++k4) { const int kj0 = 32 * wave + 4 * k4, trow = (blk - 1) * 128 + kj0; unsigned v[4];
#pragma unroll
        for (int k = 0; k < 4; ++k) v[k] = (trow >= 0) ? (unsigned)pb[(size_t)(trow + k) * NPROJ + PC_SV + kvh * 64 + lane] : 0u;
        u32x2 w; w.x = v[0] | (v[1] << 16); w.y = v[2] | (v[3] << 16);
        *(LAS u32x2*)(lds + SW_VT + lane * 520 + kj0 * 2) = w; }
    { const int g = tid >> 7, dist = tid & 127; BIAS[tid] = rel_bias[T5B[dist] * 8 + kvh * 4 + g]; }
    __syncthreads();
#pragma unroll 1
    for (int uu = 0; uu < 2; ++uu) {
        const int u = 2 * wave + uu, g = u >> 2, qt = u & 3, head = kvh * 4 + g;
        const size_t qrow = (size_t)b * SEQ + blk * 128 + 32 * qt + r;
        bf16x8 qf[4];
#pragma unroll
        for (int s = 0; s < 4; ++s) qf[s] = *(const bf16x8*)(PROJ + qrow * NPROJ + PC_SQ + head * 64 + 16 * s + 8 * hi);
        f32x16 S[5];
#pragma unroll
        for (int t = 0; t < 5; ++t) {
#pragma unroll
            for (int q = 0; q < 16; ++q) S[t][q] = 0.f;
#pragma unroll
            for (int s = 0; s < 4; ++s) { const bf16x8 a = *(const LAS bf16x8*)(lds + SW_KS + (32 * (qt + t) + r) * 144 + (16 * s + 8 * hi) * 2); S[t] = MFMA32(a, qf[s], S[t]); } }
        const float sink = sinks[head]; float m = sink;
#pragma unroll
        for (int t = 0; t < 5; ++t)
#pragma unroll
            for (int q = 0; q < 16; ++q) { const int kr = crow(q, hi), dist = 128 + r - kr - 32 * t; const bool ok = (dist >= 0) && (dist < 128) && (blk > 0 || 32 * (qt + t) + kr >= 128);
                const float sv = ok ? S[t][q] * 0.125f + BIAS[g * 128 + (dist & 127)] : -1e30f; S[t][q] = sv; m = fmaxf(m, sv); }
        m = fmaxf(m, __shfl_xor(m, 32));
        float l = 0.f;
#pragma unroll
        for (int t = 0; t < 5; ++t)
#pragma unroll
            for (int q = 0; q < 16; ++q) { const float p = __expf(S[t][q] - m); S[t][q] = p; l += p; }
        l += __shfl_xor(l, 32); l += __expf(sink - m);
        f32x16 O[2];
#pragma unroll
        for (int dt = 0; dt < 2; ++dt)
#pragma unroll
            for (int q = 0; q < 16; ++q) O[dt][q] = 0.f;
#pragma unroll
        for (int t = 0; t < 5; ++t)
#pragma unroll
            for (int s2 = 0; s2 < 2; ++s2) { u32x4 pw;
#pragma unroll
                for (int jj = 0; jj < 4; ++jj) pw[jj] = cvtpk(S[t][8 * s2 + 2 * jj], S[t][8 * s2 + 2 * jj + 1]);
                const bf16x8 pf = __builtin_bit_cast(bf16x8, pw);
#pragma unroll
                for (int dt = 0; dt < 2; ++dt) { const LAS unsigned char* vr = lds + SW_VT + (32 * dt + r) * 520 + (32 * (qt + t) + 16 * s2 + 4 * hi) * 2;
                    const u32x2 lo = *(const LAS u32x2*)vr, h2 = *(const LAS u32x2*)(vr + 16); const u32x4 av = (u32x4){lo.x, lo.y, h2.x, h2.y};
                    O[dt] = MFMA32(__builtin_bit_cast(bf16x8, av), pf, O[dt]); } }
        const float rl = 1.f / l;
#pragma unroll
        for (int dt = 0; dt < 2; ++dt)
#pragma unroll
            for (int g4 = 0; g4 < 4; ++g4) { u32x2 w; w.x = cvtpk(O[dt][4 * g4] * rl, O[dt][4 * g4 + 1] * rl); w.y = cvtpk(O[dt][4 * g4 + 2] * rl, O[dt][4 * g4 + 3] * rl);
                *(u32x2*)(MIX + qrow * DM + 512 + head * 64 + 32 * dt + 8 * g4 + 4 * hi) = w; }
    }
    __syncthreads();
}

struct Args { const float* in[17]; float* out; unsigned char* ws; int ph_lo, ph_hi, use_bar, pad; };
enum { I_X = 0, I_C, I_NORMW, I_ADAW, I_ADAB, I_WIN, I_WGATE, I_BGATE, I_GNW, I_SINKS, I_WOUT, I_RELB, I_POOLW, I_POOLS, I_W1, I_W2, I_FNW };
constexpr int NPHASE = 16;

__global__ void __launch_bounds__(NTHR, 2) mk_fwd(Args args) {
    extern __shared__ __attribute__((aligned(16))) unsigned char lds_raw[];
    LAS unsigned char* lds = (LAS unsigned char*)lds_raw;
    volatile LAS unsigned* MISC = (volatile LAS unsigned*)(lds + MISC_OFF);
    const int tid = threadIdx.x, lane = tid & 63, wave = __builtin_amdgcn_readfirstlane(tid >> 6);
    const int G = gridDim.x, bx = blockIdx.x;
    const int vcu = (G % 8 == 0) ? (bx % 8) * (G / 8) + bx / 8 : bx;
    const int gw = vcu * NWAVES + wave, NGW = G * NWAVES;
    unsigned char* ws = args.ws;
    unsigned* ctl = (unsigned*)(ws + WS_CTL);
    float* MOD = (float*)(ws + WS_MOD);
    bf16_t* WIN_T = (bf16_t*)(ws + WS_WIN); bf16_t* WOUT_T = (bf16_t*)(ws + WS_WOUT); bf16_t* W1_T = (bf16_t*)(ws + WS_W1); bf16_t* W2_T = (bf16_t*)(ws + WS_W2); bf16_t* WP_T = (bf16_t*)(ws + WS_WP);
    bf16_t* H = (bf16_t*)(ws + WS_H); bf16_t* PROJ = (bf16_t*)(ws + WS_PROJ); bf16_t* MIX = (bf16_t*)(ws + WS_MIX); bf16_t* HID = (bf16_t*)(ws + WS_HID); bf16_t* POOL = (bf16_t*)(ws + WS_POOL);
    float* DS = (float*)(ws + WS_DS); float* DEC = (float*)(ws + WS_DEC);
    const float* x = args.in[I_X]; float* X1 = args.out;

    if (tid < 64) MISC[tid] = 0u;
    __syncthreads();
    XcdBarrier bar; bar.bar = ctl + CW_BAR; bar.x = 0; bar.st = nullptr;
    if (args.use_bar) bar = xcd_barrier_post(ctl + CW_BAR, MISC + 8);
    const int lo = args.ph_lo, hi = args.ph_hi;
#define IN(k) (lo <= (k) && (k) < hi)
#define SEAM(k) do { if (IN(k) && IN((k) + 1)) xcd_barrier(bar); } while (0)

    if (IN(0)) {
        if (bx < 192) p0_mod_unit(bx, args.in[I_C], args.in[I_ADAW], args.in[I_ADAB], MOD, lds, tid, wave, lane);
        LAS float* scr = (LAS float*)(lds + wave * 16384);
        constexpr int I_IN = 16 * 72, I_GF = 16 * 8, I_OUT = 16 * 32, I_1 = 16 * 128, I_2 = 64 * 32, I_P = 4 * 8;
        constexpr int NITEMS = I_IN + I_GF + I_OUT + 2 * I_1 + 2 * I_2 + 4 * I_P;
        for (int it = gw; it < NITEMS; it += NGW) {
            int r = it;
            if (r < I_IN) { const int kb = r / 72, nb = r % 72, n0 = nb * 32; p0_transpose_item(args.in[I_WIN], INCOLS, n0 < 1536 ? n0 : n0 + 16, WIN_T, 1024, n0, kb * 64, scr, lane); continue; } r -= I_IN;
            if (r < I_GF) { const int kb = r / 8, nb = r % 8; p0_gatefold_item(args.in[I_WIN], args.in[I_WGATE], WIN_T, nb * 32, kb * 64, scr, lane); continue; } r -= I_GF;
            if (r < I_OUT) { const int kb = r / 32, nb = r % 32; p0_transpose_item(args.in[I_WOUT], 1024, nb * 32, WOUT_T, 1024, nb * 32, kb * 64, scr, lane); continue; } r -= I_OUT;
            if (r < 2 * I_1) { const int l = r / I_1; r -= l * I_1; const int kb = r / 128, nb = r % 128; p0_transpose_item(args.in[I_W1] + (size_t)l * 1024 * 4096, 4096, nb * 32, W1_T + (size_t)l * 4096 * 1024, 1024, nb * 32, kb * 64, scr, lane); continue; } r -= 2 * I_1;
            if (r < 2 * I_2) { const int l = r / I_2; r -= l * I_2; const int kb = r / 32, nb = r % 32; p0_transpose_item(args.in[I_W2] + (size_t)l * 4096 * 1024, 1024, nb * 32, W2_T + (size_t)l * 1024 * 4096, 4096, nb * 32, kb * 64, scr, lane); continue; } r -= 2 * I_2;
            { const int gi = r / I_P; r -= gi * I_P; const int kb = r / 8, nb = r % 8; p0_transpose_item(args.in[I_POOLW] + (size_t)gi * 65536, 256, nb * 32, WP_T + (size_t)gi * 65536, 256, nb * 32, kb * 64, scr, lane); }
        }
    }
    SEAM(0);
    if (IN(1)) norm_rows(x, H, args.in[I_NORMW] + 0 * 1024, MOD + 0 * 4 * 3072, gw, NGW, lane);
    SEAM(1);
    if (IN(2)) { pg8::Gemm g{H, WIN_T, 1024, 1024, 1024, 0}; pg8::StaticOrder S; S.init(MTOK, NPROJ, G, bx);
        pg8::EpiBf16<0> E{PROJ, NPROJ}; pg8::gemm_phase<pg8::EpiBf16<0>, true, true>(lds, g, S, E); }
    SEAM(2);
    if (IN(3)) {
        for (int it = gw; it < 2048; it += NGW) gla_g1_item(it, PROJ, args.in[I_BGATE], DS, DEC, lds + wave * 18432, lane);
        __syncthreads();
        for (int it = bx; it < 512; it += G) swa_item(it, PROJ, args.in[I_RELB], args.in[I_SINKS], MIX, lds, tid, wave, lane);
    }
    SEAM(3);
    if (IN(4)) gla_scan(DS, DEC, bx, G, tid);
    SEAM(4);
    if (IN(5)) gla_g3_phase(PROJ, args.in[I_BGATE], DS, args.in[I_GNW], MIX, lds, bx, G, wave, lane);
    SEAM(5);
    if (IN(6)) { pg8::Gemm g{MIX, WOUT_T, 1024, 1024, 1024, 0}; pg8::StaticOrder S; S.init(MTOK, DM, G, bx);
        pg8::EpiResGate E{x, X1, MOD + 0 * 4 * 3072, nullptr}; pg8::gemm_phase<pg8::EpiResGate, true, true>(lds, g, S, E); }
    SEAM(6);
    if (IN(7)) norm_rows(X1, H, args.in[I_NORMW] + 1 * 1024, MOD + 1 * 4 * 3072, gw, NGW, lane);
    SEAM(7);
    if (IN(8)) { pg8::Gemm g{H, W1_T, 1024, 1024, 1024, 0}; pg8::StaticOrder S; S.init(MTOK, FF, G, bx);
        pg8::EpiBf16<2> E{HID, FF}; pg8::gemm_phase<pg8::EpiBf16<2>, true, true>(lds, g, S, E); }
    SEAM(8);
    if (IN(9)) { pg8::Gemm g{HID, W2_T, 4096, 4096, 4096, 0}; pg8::StaticOrder S; S.init(MTOK, DM, G, bx);
        pg8::EpiResGate E{X1, X1, MOD + 1 * 4 * 3072, nullptr}; pg8::gemm_phase<pg8::EpiResGate, true, true>(lds, g, S, E); }
    SEAM(9);
    if (IN(10)) { for (int tile = bx; tile < 256; tile += G) pool_tile(tile, X1, POOL, args.in[I_NORMW] + 2 * 1024, MOD + 2 * 4 * 3072, lds, tid, wave, lane); }
    SEAM(10);
    if (IN(11)) { pg8::Gemm g{POOL, WP_T, 1024, 256, 256, 256}; pg8::StaticOrder S; S.init(MTOK, DM, G, bx);
        pg8::EpiResGate E{X1, X1, MOD + 2 * 4 * 3072, args.in[I_POOLS]}; pg8::gemm_phase<pg8::EpiResGate, true, true>(lds, g, S, E); }
    SEAM(11);
    if (IN(12)) norm_rows(X1, H, args.in[I_NORMW] + 3 * 1024, MOD + 3 * 4 * 3072, gw, NGW, lane);
    SEAM(12);
    if (IN(13)) { pg8::Gemm g{H, W1_T + (size_t)4096 * 1024, 1024, 1024, 1024, 0}; pg8::StaticOrder S; S.init(MTOK, FF, G, bx);
        pg8::EpiBf16<2> E{HID, FF}; pg8::gemm_phase<pg8::EpiBf16<2>, true, true>(lds, g, S, E); }
    SEAM(13);
    if (IN(14)) { pg8::Gemm g{HID, W2_T + (size_t)1024 * 4096, 4096, 4096, 4096, 0}; pg8::StaticOrder S; S.init(MTOK, DM, G, bx);
        pg8::EpiResGate E{X1, X1, MOD + 3 * 4 * 3072, nullptr}; pg8::gemm_phase<pg8::EpiResGate, true, true>(lds, g, S, E); }
    SEAM(14);
    if (IN(15)) final_norm_rows(X1, args.in[I_FNW], gw, NGW, lane);
#undef IN
#undef SEAM
}

#ifndef MK_N_LAUNCHES
#define MK_N_LAUNCHES 1
#endif
extern "C" void kernel_launch(void* const* d_in, const int* in_sizes, int n_in, void* d_out, int out_size, void* d_ws, size_t ws_size, hipStream_t stream) {
    static int grid = 0;
    if (grid == 0) {
        if (n_in != 17 || in_sizes[0] != MTOK * DM || out_size != MTOK * DM || ws_size < WS_END) { fprintf(stderr, "kernel_launch: unexpected shapes (n_in %d, in0 %d, out %d, ws %zu)\n", n_in, n_in > 0 ? in_sizes[0] : -1, out_size, ws_size); grid = -1; return; }
        int dev = 0, cus = 0, per_cu = 0;
        if (hipGetDevice(&dev) != hipSuccess || hipDeviceGetAttribute(&cus, hipDeviceAttributeMultiprocessorCount, dev) != hipSuccess) { grid = -1; return; }
        if (hipFuncSetAttribute((const void*)mk_fwd, hipFuncAttributeMaxDynamicSharedMemorySize, LDS_BYTES) != hipSuccess) { fprintf(stderr, "kernel_launch: hipFuncSetAttribute failed\n"); grid = -1; return; }
        if (hipOccupancyMaxActiveBlocksPerMultiprocessor(&per_cu, (const void*)mk_fwd, NTHR, LDS_BYTES) != hipSuccess || per_cu < 1) { fprintf(stderr, "kernel_launch: occupancy query says %d\n", per_cu); per_cu = 1; }
        (void)hipGetLastError();
        grid = cus;
    }
    if (grid < 0) return;
    (void)hipMemsetAsync((char*)d_ws + WS_CTL, 0, CTL_ZERO_BYTES, stream);
    Args a{};
    for (int i = 0; i < 17; ++i) a.in[i] = (const float*)d_in[i];
    a.out = (float*)d_out; a.ws = (unsigned char*)d_ws;
#if MK_N_LAUNCHES == 1
    a.ph_lo = 0; a.ph_hi = NPHASE; a.use_bar = 1;
    void* kargs[] = {&a};
    hipError_t e = hipLaunchCooperativeKernel((const void*)mk_fwd, dim3(grid), dim3(NTHR), kargs, LDS_BYTES, stream);
    if (e != hipSuccess) fprintf(stderr, "kernel_launch: cooperative launch failed: %s\n", hipGetErrorString(e));
#else
    for (int p = 0; p < NPHASE; ++p) { if (p == 5) continue; a.ph_lo = p; a.ph_hi = p + 1; a.use_bar = 0;
        hipLaunchKernelGGL(mk_fwd, dim3(grid), dim3(NTHR), LDS_BYTES, stream, a); }
#endif
}
```

```cpp
#include <hip/hip_runtime.h>
#include <cstdio>
#include <cstdint>

#define LAS __attribute__((address_space(3)))
typedef unsigned short bf16_t;
typedef short bf16x8 __attribute__((ext_vector_type(8)));
typedef float f32x4 __attribute__((ext_vector_type(4)));
typedef float f32x2 __attribute__((ext_vector_type(2)));
typedef float f32x16 __attribute__((ext_vector_type(16)));
typedef unsigned u32x4 __attribute__((ext_vector_type(4)));
typedef unsigned u32x2 __attribute__((ext_vector_type(2)));
typedef __bf16 bf16x2_t __attribute__((ext_vector_type(2)));
#define DI __device__ __forceinline__

constexpr int NB = 4, SEQ = 8192, DM = 1024, MTOK = NB * SEQ, FF = 4096, NPROJ = 2560, INCOLS = 2320;
constexpr int PC_GQ = 0, PC_GK = 256, PC_GV = 512, PC_GG = 1024, PC_SQ = 1536, PC_SK = 2048, PC_SV = 2176, PC_GL = 2304;
constexpr float EPS = 1e-6f;
constexpr int NWAVES = 8, NTHR = 512;
constexpr int HIDLD = 4160;

constexpr size_t MiB = 1u << 20;
constexpr size_t WS_CTL = 0, CTL_ZERO_BYTES = 2 * MiB;
constexpr size_t WS_MOD = 2 * MiB;
constexpr size_t WS_BIAS = 2 * MiB + 512 * 1024;
constexpr size_t WS_WIN = 3 * MiB;
constexpr size_t WS_WOUT = 8 * MiB;
constexpr size_t WS_W1 = 10 * MiB;
constexpr size_t WS_W2 = 26 * MiB;
constexpr size_t WS_WP = 42 * MiB;
constexpr size_t WS_DEC = 43 * MiB;
constexpr size_t WS_H = 48 * MiB;
constexpr size_t WS_PROJ = 112 * MiB;
constexpr size_t WS_MIX = 272 * MiB;
constexpr size_t WS_DS = 336 * MiB;
constexpr size_t WS_HID = 112 * MiB;
constexpr size_t WS_POOL = 48 * MiB;
constexpr size_t WS_X1B = 400 * MiB;
constexpr size_t WS_WINF = 80 * MiB;
constexpr size_t WS_W1F0 = 48 * MiB;
constexpr size_t WS_W1F1 = 464 * MiB;
constexpr size_t WS_WPF = 44 * MiB;
constexpr size_t WS_END = 496 * MiB;
constexpr int CW_ZEROS = 65536;
constexpr int CW_BIAS = 327680;
constexpr int CW_RS = 131072;
constexpr int CW_BAR = 4096;

constexpr int RING_BYTES = 155648;
constexpr int MISC_OFF = RING_BYTES;
constexpr int LDS_BYTES = 163840;

DI unsigned cvtpk(float lo, float hi) { f32x2 v = {lo, hi}; bf16x2_t b = __builtin_convertvector(v, bf16x2_t); return __builtin_bit_cast(unsigned, b); }
DI void st16_wt(void* base  , unsigned byte_off, u32x4 v) { asm volatile("s_nop 4\n\tglobal_store_dwordx4 %0, %1, %2 sc1\n\ts_nop 1" :: "v"(byte_off), "v"(v), "s"(base) : "memory"); }
DI int lane_id() { return (int)__builtin_amdgcn_mbcnt_hi(~0u, __builtin_amdgcn_mbcnt_lo(~0u, 0u)); }
DI int fresh_tid(int wave) { return wave * 64 + lane_id(); }
DI int opaque_lane() { unsigned m = ~0u; asm volatile("" : "+s"(m)); return (int)__builtin_amdgcn_mbcnt_hi(m, __builtin_amdgcn_mbcnt_lo(m, 0u)); }
DI void st8_wt(void* base  , unsigned byte_off, u32x2 v) { asm volatile("s_nop 4\n\tglobal_store_dwordx2 %0, %1, %2 sc1\n\ts_nop 1" :: "v"(byte_off), "v"(v), "s"(base) : "memory"); }
DI float bflo(unsigned w) { return __uint_as_float(w << 16); }
DI float bfhi(unsigned w) { return __uint_as_float(w & 0xffff0000u); }
DI float bf2f(bf16_t u) { return __uint_as_float((unsigned)u << 16); }
DI float wave_sum(float v) {
#pragma unroll
    for (int o = 1; o < 64; o <<= 1) v += __shfl_xor(v, o);
    return v;
}
DI float fexp(float x) { return __builtin_amdgcn_exp2f(x * 1.4426950408889634f); }
DI float flog(float x) { return __builtin_amdgcn_logf(x) * 0.6931471805599453f; }
DI float silu_f(float x) { return x * __builtin_amdgcn_rcpf(1.f + fexp(-x)); }
DI float logsigmoid_f(float x) { return fminf(x, 0.f) - flog(1.f + fexp(-fabsf(x))); }

__device__ const unsigned char T5B[128] = {0,1,2,3,4,5,6,7,8,9,10,11,12,13,14,15,16,16,16,17,17,18,18,18,19,19,19,20,20,20,20,21,21,21,21,22,22,22,22,22,23,23,23,23,23,23,24,24,24,24,24,24,25,25,25,25,25,25,25,26,26,26,26,26,26,26,26,27,27,27,27,27,27,27,27,27,27,28,28,28,28,28,28,28,28,28,28,29,29,29,29,29,29,29,29,29,29,29,29,30,30,30,30,30,30,30,30,30,30,30,30,30,30,31,31,31,31,31,31,31,31,31,31,31,31,31,31,31};

namespace pg8 {
constexpr int BM = 256, BK = 64, HALF = 128, HTB = HALF * BK * 2, STAGE_BYTES = 8 * HTB, NXCD = 8, WGM = 8;
__host__ __device__ __forceinline__ int lds_byte(int r, int c) { const int st = (r >> 4) * 2 + (c >> 5), rr = r & 15, cc = c & 31, ob = rr * 64 + cc * 2; return st * 1024 + (ob ^ (((ob >> 9) & 1) << 5)); }
__host__ __device__ __forceinline__ void stage_rc(int b, int& R, int& C) { const int st = b / 1024, sb = b % 1024, swz = sb ^ (((sb >> 9) & 1) << 5); R = (st >> 1) * 16 + swz / 64; C = (st & 1) * 32 + (swz % 64) / 2; }
__host__ __device__ __forceinline__ int perm32(int rho) { const int n = rho >> 4, i = rho & 15; return 8 * (i >> 2) + 4 * n + (i & 3); }

struct Unit { int pm, pn, rp, lst; };
struct Gemm { const bf16_t* A; const bf16_t* Bt; int lda, ldb, K, a_pn_koff; size_t b_bstride = 0; };

struct StaticOrder {
    int nM, nN, nwg, G, c, reps;
    __host__ __device__ void init(int M, int N, int G_, int c_, int reps_ = 1) { nM = M / BM; nN = N / BM; nwg = nM * nN; G = G_; c = c_; reps = reps_; }
    __host__ __device__ bool next(int i, Unit& u) const {
        int L = i * G + c; if (L >= nwg * reps) return false;
        u.rp = (reps > 1) ? L / nwg : 0; L -= u.rp * nwg;
        const int wgid = (L % NXCD) * (nwg / NXCD) + L / NXCD;
        const int nig = WGM * nN, gid = wgid / nig, idx = wgid - gid * nig;
        u.pm = gid * WGM + (idx % WGM); u.pn = idx / WGM; return true;
    }
};

DI u32x4 ror8(u32x4 v) { u32x4 r;
#pragma unroll
    for (int k = 0; k < 4; ++k) r[k] = (unsigned)__builtin_amdgcn_update_dpp(0, (int)v[k], 0x128, 0xf, 0xf, false);
    return r; }
DI u32x4 sel4(bool c, u32x4 a, u32x4 b) { u32x4 r;
#pragma unroll
    for (int k = 0; k < 4; ++k) r[k] = c ? a[k] : b[k];
    return r; }
template <int ACT  > struct EpiBf16 {
    static constexpr bool PERM = true;
    bf16_t* O; int ldc; const float* rowss; const float* bias; int nbias;
    __device__ __forceinline__ void operator()(const f32x4 (&acc)[2][2][4][2], const Unit& u, int wr, int wc, int fr, int fq) const {
        { const int l_ = opaque_lane(); fr = l_ & 15; fq = l_ >> 4; }
        const int row0 = u.pm * BM + wr * 64 + fr; const int col0 = u.pn * BM + wc * 64 + 8 * fq;
        const bool lo = fr < 8;
        f32x4 bv[2][2]; float rs[2][4];
#pragma unroll
        for (int ai = 0; ai < 2; ++ai)
#pragma unroll
            for (int m = 0; m < 4; ++m) rs[ai][m] = rowss[row0 + ai * HALF + m * 16];
#pragma unroll
        for (int bj = 0; bj < 2; ++bj)
#pragma unroll
            for (int n = 0; n < 2; ++n) bv[bj][n] = *(const f32x4*)(bias + (size_t)(u.pm >> 5) * nbias + col0 + bj * 32 + 4 * n);
#pragma unroll
        for (int ai = 0; ai < 2; ++ai)
#pragma unroll
            for (int m = 0; m < 4; ++m) rs[ai][m] = rsqrtf(rs[ai][m] * (1.f / DM) + EPS);
        const unsigned obase = ((unsigned)(u.pm * BM + wr * 64 + (fr & 7)) * (unsigned)ldc + (unsigned)(col0 + (lo ? 0 : 32))) * 2u;
#pragma unroll
        for (int ai = 0; ai < 2; ++ai)
#pragma unroll
            for (int m = 0; m < 4; ++m) { const float rstd = rs[ai][m]; u32x4 w[2];
#pragma unroll
                for (int bj = 0; bj < 2; ++bj) { f32x4 v0 = acc[ai][bj][m][0] * rstd + bv[bj][0], v1 = acc[ai][bj][m][1] * rstd + bv[bj][1];
                    if (ACT == 2) {
#pragma unroll
                        for (int e = 0; e < 4; ++e) { const float a = fmaxf(v0[e], 0.f), b = fmaxf(v1[e], 0.f); v0[e] = a * a; v1[e] = b * b; } }
                    w[bj].x = cvtpk(v0[0], v0[1]); w[bj].y = cvtpk(v0[2], v0[3]); w[bj].z = cvtpk(v1[0], v1[1]); w[bj].w = cvtpk(v1[2], v1[3]); }
                const u32x4 rcv = ror8(sel4(lo, w[1], w[0]));
                const unsigned rp = obase + (unsigned)((ai * HALF + m * 16) * 2) * (unsigned)ldc;
                if (u.lst) { st16_wt(O, rp, sel4(lo, w[0], rcv)); st16_wt(O, rp + 16u * (unsigned)ldc, sel4(lo, rcv, w[1])); }
                else { __builtin_nontemporal_store(sel4(lo, w[0], rcv), (u32x4*)((char*)O + rp)); __builtin_nontemporal_store(sel4(lo, rcv, w[1]), (u32x4*)((char*)O + (rp + 16u * (unsigned)ldc))); } }
    }
};
template <bool BASE_F32, bool WRITE_XG> struct EpiRes {
    static constexpr bool PERM = true;
    const void* base; bf16_t* xres; bf16_t* xg; const float* mod_ls; const float* colscale; const float* gnw; const float* mod_next; float* rowss_next; const float* zeros;
    __device__ __forceinline__ void operator()(const f32x4 (&acc)[2][2][4][2], const Unit& u, int wr, int wc, int fr, int fq) const {
        { const int l_ = opaque_lane(); fr = l_ & 15; fq = l_ >> 4; }
        const int b = u.pm >> 5;
        const float* gate = ((u.rp && !BASE_F32) ? zeros : mod_ls) + (size_t)b * 3072 + 2048;
        const int col0 = u.pn * BM + wc * 64 + 8 * fq, rowb = u.pm * BM + wr * 64 + fr;
        float ss[2][4];
#pragma unroll
        for (int ai = 0; ai < 2; ++ai)
#pragma unroll
            for (int m = 0; m < 4; ++m) ss[ai][m] = 0.f;
#pragma unroll
        for (int bj = 0; bj < 2; ++bj) {
            f32x4 gv[2], gx[2];
#pragma unroll
            for (int n = 0; n < 2; ++n) { const int c = col0 + bj * 32 + 4 * n; gv[n] = *(const f32x4*)(gate + c); if (colscale) gv[n] = gv[n] * *(const f32x4*)(colscale + c);
                if (WRITE_XG) gx[n] = *(const f32x4*)(gnw + c) * (*(const f32x4*)(mod_next + (size_t)b * 3072 + 1024 + c) + 1.0f); }
            constexpr int NBATCH = BASE_F32 ? 2 : 1;
#pragma unroll
            for (int sb = 0; sb < NBATCH; ++sb) {
                constexpr int NR = 8 / NBATCH;
                f32x4 b0[NR], b1[NR];
#pragma unroll
                for (int q = 0; q < NR; ++q) { const int rr = sb * NR + q, ai = rr >> 2, m = rr & 3; const unsigned off = (unsigned)(rowb + ai * HALF + m * 16) * DM + (unsigned)(col0 + bj * 32);
                    if (BASE_F32) { const char* bp = (const char*)base + off * 4u; b0[q] = *(const f32x4*)bp; b1[q] = *(const f32x4*)(bp + 16); }
                    else { const u32x4 w = *(const u32x4*)((const char*)base + off * 2u); b0[q] = __builtin_bit_cast(f32x4, w); } }
#pragma unroll
                for (int q = 0; q < NR; ++q) { const int rr = sb * NR + q, ai = rr >> 2, m = rr & 3; const unsigned off = (unsigned)(rowb + ai * HALF + m * 16) * DM + (unsigned)(col0 + bj * 32);
                    f32x4 x0, x1;
                    if (BASE_F32) { x0 = b0[q]; x1 = b1[q]; }
                    else { const u32x4 w = __builtin_bit_cast(u32x4, b0[q]); x0 = (f32x4){bflo(w.x), bfhi(w.x), bflo(w.y), bfhi(w.y)}; x1 = (f32x4){bflo(w.z), bfhi(w.z), bflo(w.w), bfhi(w.w)}; }
                    const f32x4 v0 = x0 + gv[0] * acc[ai][bj][m][0], v1 = x1 + gv[1] * acc[ai][bj][m][1];
                    ss[ai][m] += (v0[0] * v0[0] + v0[1] * v0[1]) + (v0[2] * v0[2] + v0[3] * v0[3]) + (v1[0] * v1[0] + v1[1] * v1[1]) + (v1[2] * v1[2] + v1[3] * v1[3]);
                    u32x4 w; w.x = cvtpk(v0[0], v0[1]); w.y = cvtpk(v0[2], v0[3]); w.z = cvtpk(v1[0], v1[1]); w.w = cvtpk(v1[2], v1[3]);
                    if (u.lst) st16_wt(xres, off * 2u, w); else *(u32x4*)((char*)xres + off * 2u) = w;
                    if (WRITE_XG) { const f32x4 g0 = v0 * gx[0], g1 = v1 * gx[1]; u32x4 wg; wg.x = cvtpk(g0[0], g0[1]); wg.y = cvtpk(g0[2], g0[3]); wg.z = cvtpk(g1[0], g1[1]); wg.w = cvtpk(g1[2], g1[3]);
                        if (u.lst) st16_wt(xg, off * 2u, wg); else *(u32x4*)((char*)xg + off * 2u) = wg; }
                    __builtin_amdgcn_sched_barrier(0); }
            }
        }
#pragma unroll
        for (int ai = 0; ai < 2; ++ai)
#pragma unroll
            for (int m = 0; m < 4; ++m) { float t = ss[ai][m]; t += __shfl_xor(t, 16); t += __shfl_xor(t, 32);
                if (fq == 0 && u.rp == 0 && rowss_next) atomicAdd(rowss_next + rowb + ai * HALF + m * 16, t); }
    }
};

template <class Epi, bool ALIGN_EPI, bool SP2>
__device__ __forceinline__ void gemm_phase(LAS unsigned char* lds, const Gemm g, const StaticOrder& S, const Epi& E, int wave) {
    const int wid = wave, lane = lane_id(), tid = wid * 64 + lane, wr = wid >> 2, wc = wid & 3, fr = lane & 15, fq = lane >> 4;
    int K = g.K; asm volatile("" : "+s"(K));
    const int nt = K / BK;
    unsigned voffA[2], voffB[2];
#pragma unroll
    for (int i = 0; i < 2; ++i) { int R, C; stage_rc(tid * 16 + i * 8192, R, C); const int Rb = Epi::PERM ? (64 * (R >> 5) + perm32(R & 31)) : R;
        voffA[i] = (unsigned)(R * g.lda + C) * 2u; voffB[i] = (unsigned)(Rb * g.ldb + C) * 2u; }
    const size_t kstep = (size_t)(BK * 2);
    const size_t hstepA = (size_t)HALF * g.lda * 2, hstepB = (size_t)(Epi::PERM ? 32 : HALF) * g.ldb * 2;
    const size_t tstepA = 2 * hstepA, tstepB = (size_t)BM * g.ldb * 2;
    const unsigned ldsw = (unsigned)wid * 1024u;
    const int aoff = lds_byte(wr * 64 + fr, fq * 8), boff = lds_byte(wc * 32 + fr, fq * 8);
#define PG8_SA(b, h) (((b) * 2 + (h)) * HTB)
#define PG8_SB(b, h) ((4 + (b) * 2 + (h)) * HTB)
#define PG8_STAGE(bufoff, gbase, voff) do { _Pragma("unroll") for (int _i = 0; _i < 2; ++_i) \
        __builtin_amdgcn_global_load_lds((const unsigned*)((const char*)(gbase) + (voff)[_i]), (LAS unsigned*)(lds + (bufoff) + ldsw + _i * 8192), 16, 0, 0); } while (0)
#define PG8_LDA(dst, b, h) do { _Pragma("unroll") for (int m = 0; m < 4; ++m) _Pragma("unroll") for (int k = 0; k < 2; ++k) dst[m][k] = *(const LAS bf16x8*)(lds + PG8_SA(b, h) + aoff + m * 2048 + k * 1024); } while (0)
#define PG8_LDB(dst, b, h) do { _Pragma("unroll") for (int n = 0; n < 2; ++n) _Pragma("unroll") for (int k = 0; k < 2; ++k) dst[n][k] = *(const LAS bf16x8*)(lds + PG8_SB(b, h) + boff + n * 2048 + k * 1024); } while (0)
#define PG8_MMA(ai, bj, At, Bt) do { __builtin_amdgcn_s_setprio(1); _Pragma("unroll") for (int m = 0; m < 4; ++m) _Pragma("unroll") for (int n = 0; n < 2; ++n) _Pragma("unroll") for (int k = 0; k < 2; ++k) \
        acc[ai][bj][m][n] = __builtin_amdgcn_mfma_f32_16x16x32_bf16(Bt[n][k], At[m][k], acc[ai][bj][m][n], 0, 0, 0); __builtin_amdgcn_s_setprio(0); } while (0)
#define PG8_WAIT_V(n) asm volatile("s_waitcnt vmcnt(" #n ")" ::: "memory")
#define PG8_WAIT_L(n) asm volatile("s_waitcnt lgkmcnt(" #n ")" ::: "memory")
#define PG8_BAR __builtin_amdgcn_s_barrier()
#define PG8_SCHED __builtin_amdgcn_sched_barrier(0)
    Unit cur, nxt; int ui = 0;
    if (!S.next(0, cur)) return;
    f32x4 acc[2][2][4][2];
#pragma unroll
    for (int a = 0; a < 2; ++a)
#pragma unroll
        for (int b = 0; b < 2; ++b)
#pragma unroll
            for (int m = 0; m < 4; ++m)
#pragma unroll
                for (int n = 0; n < 2; ++n) acc[a][b][m][n] = (f32x4){0.f, 0.f, 0.f, 0.f};
    bf16x8 At[4][2], B0[2][2], B1[2][2];
    const char* cA = (const char*)g.A + (size_t)cur.pm * tstepA + (size_t)cur.pn * g.a_pn_koff * 2; const char* cB = (const char*)g.Bt + (size_t)(cur.pm >> 5) * g.b_bstride * 2 + (size_t)cur.pn * tstepB;
    if constexpr (SP2) {
        PG8_STAGE(PG8_SB(0, 0), cB, voffB); PG8_STAGE(PG8_SB(0, 1), cB + hstepB, voffB); PG8_STAGE(PG8_SA(0, 0), cA, voffA); PG8_STAGE(PG8_SA(0, 1), cA + hstepA, voffA);
        if (wr == 1) PG8_BAR;
        PG8_WAIT_V(2); PG8_BAR;
        PG8_STAGE(PG8_SB(1, 0), cB + kstep, voffB); PG8_STAGE(PG8_SA(1, 0), cA + kstep, voffA); PG8_STAGE(PG8_SB(1, 1), cB + hstepB + kstep, voffB);
        PG8_WAIT_V(6); PG8_BAR;
    } else {
        PG8_STAGE(PG8_SB(0, 0), cB, voffB); PG8_STAGE(PG8_SA(0, 0), cA, voffA); PG8_STAGE(PG8_SB(0, 1), cB + hstepB, voffB); PG8_STAGE(PG8_SA(0, 1), cA + hstepA, voffA);
        if (wr == 1) PG8_BAR;
        PG8_WAIT_V(4); PG8_BAR;
        PG8_STAGE(PG8_SB(1, 0), cB + kstep, voffB); PG8_STAGE(PG8_SA(1, 0), cA + kstep, voffA); PG8_STAGE(PG8_SB(1, 1), cB + hstepB + kstep, voffB);
        PG8_WAIT_V(6); PG8_BAR;
    }
    for (;;) {
        const bool has_next = S.next(ui + 1, nxt);
        const char* nA = has_next ? (const char*)g.A + (size_t)nxt.pm * tstepA + (size_t)nxt.pn * g.a_pn_koff * 2 : cA; const char* nB = has_next ? (const char*)g.Bt + (size_t)(nxt.pm >> 5) * g.b_bstride * 2 + (size_t)nxt.pn * tstepB : cB;
        for (int t = 0; t < nt; t += 2) {
            const bool last = (t == nt - 2);
            const char* a1 = cA + (size_t)(t + 1) * kstep;
            const char* a2 = last ? nA : cA + (size_t)(t + 2) * kstep; const char* b2 = last ? nB : cB + (size_t)(t + 2) * kstep;
            const char* a3 = a2 + kstep; const char* b3 = b2 + kstep;
            if constexpr (SP2) {
            PG8_LDB(B0, 0, 0); PG8_LDB(B1, 0, 1); PG8_SCHED; PG8_LDA(At, 0, 0); PG8_STAGE(PG8_SA(1, 1), a1 + hstepA, voffA);
            PG8_WAIT_V(8); PG8_WAIT_L(0); PG8_BAR; PG8_MMA(0, 0, At, B0); PG8_MMA(0, 1, At, B1); PG8_BAR; PG8_SCHED;
            PG8_LDA(At, 0, 1); PG8_STAGE(PG8_SB(0, 0), b2, voffB); PG8_STAGE(PG8_SB(0, 1), b2 + hstepB, voffB); PG8_STAGE(PG8_SA(0, 0), a2, voffA);
            PG8_WAIT_V(8); PG8_WAIT_L(0); PG8_BAR; PG8_MMA(1, 0, At, B0); PG8_MMA(1, 1, At, B1); PG8_BAR; PG8_SCHED;
            PG8_LDB(B0, 1, 0); PG8_LDB(B1, 1, 1); PG8_SCHED; PG8_LDA(At, 1, 0); PG8_STAGE(PG8_SA(0, 1), a2 + hstepA, voffA);
            PG8_WAIT_V(8); PG8_WAIT_L(0); PG8_BAR; PG8_MMA(0, 0, At, B0); PG8_MMA(0, 1, At, B1); PG8_BAR; PG8_SCHED;
            PG8_LDA(At, 1, 1); PG8_STAGE(PG8_SB(1, 0), b3, voffB); PG8_STAGE(PG8_SB(1, 1), b3 + hstepB, voffB); PG8_STAGE(PG8_SA(1, 0), a3, voffA);
            PG8_WAIT_V(8); PG8_WAIT_L(0); PG8_BAR; PG8_MMA(1, 0, At, B0); PG8_MMA(1, 1, At, B1); PG8_BAR; PG8_SCHED;
            } else {
            PG8_LDB(B0, 0, 0); PG8_SCHED; PG8_LDA(At, 0, 0); PG8_STAGE(PG8_SA(1, 1), a1 + hstepA, voffA);
            PG8_WAIT_L(8); PG8_BAR; PG8_WAIT_L(0); PG8_MMA(0, 0, At, B0); PG8_BAR; PG8_SCHED;
            PG8_LDB(B1, 0, 1); PG8_STAGE(PG8_SB(0, 0), b2, voffB);
            PG8_BAR; PG8_WAIT_L(0); PG8_MMA(0, 1, At, B1); PG8_BAR;
            PG8_LDA(At, 0, 1); PG8_STAGE(PG8_SA(0, 0), a2, voffA);
            PG8_BAR; PG8_WAIT_L(0); PG8_MMA(1, 0, At, B0); PG8_BAR; PG8_SCHED;
            PG8_STAGE(PG8_SB(0, 1), b2 + hstepB, voffB);
            PG8_WAIT_V(6); PG8_BAR; PG8_MMA(1, 1, At, B1); PG8_BAR;
            PG8_LDB(B0, 1, 0); PG8_SCHED; PG8_LDA(At, 1, 0); PG8_STAGE(PG8_SA(0, 1), a2 + hstepA, voffA);
            PG8_WAIT_L(8); PG8_BAR; PG8_WAIT_L(0); PG8_MMA(0, 0, At, B0); PG8_BAR; PG8_SCHED;
            PG8_LDB(B1, 1, 1); PG8_STAGE(PG8_SB(1, 0), b3, voffB);
            PG8_BAR; PG8_WAIT_L(0); PG8_MMA(0, 1, At, B1); PG8_BAR;
            PG8_LDA(At, 1, 1); PG8_STAGE(PG8_SA(1, 0), a3, voffA);
            PG8_BAR; PG8_WAIT_L(0); PG8_MMA(1, 0, At, B0); PG8_BAR; PG8_SCHED;
            PG8_STAGE(PG8_SB(1, 1), b3 + hstepB, voffB);
            PG8_WAIT_V(6); PG8_BAR; PG8_MMA(1, 1, At, B1); PG8_BAR;
            }
        }
        if constexpr (ALIGN_EPI) { if (wr == 0) PG8_BAR; }
        cur.lst = has_next ? 0 : 1;
        E(acc, cur, wr, wc, fr, fq);
        if (!has_next) break;
#pragma unroll
        for (int a = 0; a < 2; ++a)
#pragma unroll
            for (int b = 0; b < 2; ++b)
#pragma unroll
                for (int m = 0; m < 4; ++m)
#pragma unroll
                    for (int n = 0; n < 2; ++n) acc[a][b][m][n] = (f32x4){0.f, 0.f, 0.f, 0.f};
        cur = nxt; cA = nA; cB = nB; ++ui;
        if constexpr (ALIGN_EPI) { if (wr == 1) PG8_BAR; }
    }
    PG8_WAIT_V(0);
    if constexpr (!ALIGN_EPI) { if (wr == 0) PG8_BAR; }
    PG8_BAR;
#undef PG8_SA
#undef PG8_SB
#undef PG8_STAGE
#undef PG8_LDA
#undef PG8_LDB
#undef PG8_MMA
#undef PG8_WAIT_V
#undef PG8_WAIT_L
#undef PG8_BAR
#undef PG8_SCHED
}
}

#define XB_TMO      128
#define XB_XCNT(j)  (256  + 64 * (j))
#define XB_XSUB(j)  (1280 + 64 * (j))
#define XB_XGEN(j)  (2304 + 64 * (j))
#define XB_TOP      3328
#define XB_TOPGEN   3392
#define XCD_BAR_WORDS 3456
#define XB_SPIN_CAP (1u << 18)
DI unsigned xb_ld(unsigned* p)              { return __hip_atomic_load(p, __ATOMIC_RELAXED, __HIP_MEMORY_SCOPE_AGENT); }
DI unsigned xb_add(unsigned* p, unsigned v) { return __hip_atomic_fetch_add(p, v, __ATOMIC_RELAXED, __HIP_MEMORY_SCOPE_AGENT); }
DI unsigned xb_xcc_id() { return (unsigned)__builtin_amdgcn_s_getreg((3 << 11) | 20) & 0xFu; }
#define XB_SPIN(cond, bar) do { unsigned _sp = 0; while (cond) { __builtin_amdgcn_s_sleep(1); \
    if ((++_sp & 255u) == 0u) { if (xb_ld(&(bar)[XB_TMO])) break; if (_sp > XB_SPIN_CAP) { atomicAdd(&(bar)[XB_TMO], 1u); break; } } } } while (0)
struct XcdBarrier { unsigned* bar; unsigned x; volatile LAS unsigned* st; int wave; };
DI XcdBarrier xcd_barrier_post(unsigned* bar, volatile LAS unsigned* st, int wave) {
    XcdBarrier b; b.bar = bar; b.x = xb_xcc_id(); b.st = st; b.wave = wave;
    if (wave == 0 && lane_id() == 0) st[2] = xb_add(&bar[XB_XCNT(b.x)], 1u);
    return b;
}
DI void xcd_barrier_complete(unsigned* bar, unsigned x, unsigned& nloc, unsigned& nx, unsigned& uni) {
    const unsigned G = gridDim.x * gridDim.y * gridDim.z;
    unsigned sum, cnt, mine, sp = 0u, all32 = 0u;
    for (;;) {
        sum = 0u; cnt = 0u; mine = 0u; all32 = 1u;
#pragma unroll
        for (unsigned j = 0; j < 16; ++j) { const unsigned c = xb_ld(&bar[XB_XCNT(j)]); sum += c; cnt += (c > 0u) ? 1u : 0u; mine = (j == x) ? c : mine; all32 &= (c == (j < 8u ? 32u : 0u)) ? 1u : 0u; }
        if (sum == G) break;
        __builtin_amdgcn_s_sleep(1);
        if ((++sp & 255u) == 0u) { if (xb_ld(&bar[XB_TMO])) break; if (sp > XB_SPIN_CAP) { atomicAdd(&bar[XB_TMO], 1u); break; } }
    }
    nloc = mine > 0u ? mine : 1u; nx = cnt > 0u ? cnt : 1u; uni = (sum == G && G == 256u) ? all32 : 0u;
}
DI void xcd_barrier(const XcdBarrier& b, int local = 0) {
    asm volatile("s_waitcnt vmcnt(0)" ::: "memory");
    __syncthreads();
    if (b.wave == 0 && lane_id() == 0) {
        unsigned* bar = b.bar;
        __builtin_amdgcn_s_waitcnt(0);
        unsigned nloc = b.st[0], nx = b.st[1];
        if (nloc == 0u) { unsigned uni; xcd_barrier_complete(bar, b.x, nloc, nx, uni); b.st[0] = nloc; b.st[1] = nx; b.st[3] = uni; }
        const unsigned old = xb_add(&bar[XB_XSUB(b.x)], 1u);
        const unsigned gen = old / nloc;
        if (old + 1u == (gen + 1u) * nloc) {
            if (!local) {
            __builtin_amdgcn_fence(__ATOMIC_RELEASE, "agent");
            asm volatile("s_waitcnt vmcnt(0)" ::: "memory");
            const unsigned og = xb_add(&bar[XB_TOP], 1u);
            const unsigned tg = og / nx;
            if (og + 1u == (tg + 1u) * nx) xb_add(&bar[XB_TOPGEN], 1u);
            else XB_SPIN(xb_ld(&bar[XB_TOPGEN]) == tg, bar);
            }
            __builtin_amdgcn_fence(__ATOMIC_ACQUIRE, "agent");
            xb_add(&bar[XB_XGEN(b.x)], 1u);
            asm volatile("s_waitcnt vmcnt(0)" ::: "memory");
        } else {
            XB_SPIN(xb_ld(&bar[XB_XGEN(b.x)]) == gen, bar);
            __builtin_amdgcn_fence(__ATOMIC_ACQUIRE, "agent");
            asm volatile("s_waitcnt vmcnt(0)" ::: "memory");
        }
    }
    __syncthreads();
}

DI void p0_mod_unit(int unit, const float* c, const float* ada_w, const float* ada_b, float* MOD, LAS unsigned char* lds, int tid, int wave, int lane) {
    LAS float* sc = (LAS float*)lds;
    LAS float* red = (LAS float*)(lds + 16384);
    const int ls = unit >> 6, j0 = (unit & 63) * 48, ln = lane < 48 ? lane : 47;
    for (int k = tid; k < 1024; k += NTHR) {
#pragma unroll
        for (int b = 0; b < 4; ++b) sc[k * 4 + b] = silu_f(c[b * 1024 + k]);
    }
    __syncthreads();
    const float* w = ada_w + (size_t)ls * 1024 * 3072 + (size_t)(wave * 128) * 3072 + j0 + ln;
    float a0 = 0.f, a1 = 0.f, a2 = 0.f, a3 = 0.f;
#pragma unroll 1
    for (int k0 = 0; k0 < 128; k0 += 32) { float wv[32];
#pragma unroll
        for (int k = 0; k < 32; ++k) wv[k] = w[(size_t)(k0 + k) * 3072];
#pragma unroll
        for (int k = 0; k < 32; ++k) { const f32x4 s4 = *(const LAS f32x4*)(sc + (wave * 128 + k0 + k) * 4); a0 += wv[k] * s4[0]; a1 += wv[k] * s4[1]; a2 += wv[k] * s4[2]; a3 += wv[k] * s4[3]; } }
    red[(wave * 4 + 0) * 64 + lane] = a0; red[(wave * 4 + 1) * 64 + lane] = a1; red[(wave * 4 + 2) * 64 + lane] = a2; red[(wave * 4 + 3) * 64 + lane] = a3;
    __syncthreads();
    if (wave < 4 && lane < 48) { float sm = ada_b[ls * 3072 + j0 + lane];
#pragma unroll
        for (int w8 = 0; w8 < 8; ++w8) sm += red[(w8 * 4 + wave) * 64 + lane];
        MOD[((size_t)ls * 4 + wave) * 3072 + j0 + lane] = sm; }
    __syncthreads();
}
DI void p0_transpose_item(const float* W, int ldw, int src_col0, bf16_t* WT, int K, int dst_row0, int k0, LAS float* scr, int lane) {
    float wv[32];
#pragma unroll
    for (int i = 0; i < 32; ++i) { const int kk = 2 * i + (lane >> 5); wv[i] = W[(size_t)(k0 + kk) * ldw + src_col0 + (lane & 31)]; }
#pragma unroll
    for (int i = 0; i < 32; ++i) { const int kk = 2 * i + (lane >> 5); scr[kk * 33 + (lane & 31)] = wv[i]; }
    asm volatile("s_waitcnt lgkmcnt(0)" ::: "memory");
    const int c = lane & 7;
#pragma unroll
    for (int j = 0; j < 4; ++j) { const int n = (lane >> 3) + 8 * j; const LAS float* s = scr + (8 * c) * 33 + n;
        u32x4 o; o.x = cvtpk(s[0 * 33], s[1 * 33]); o.y = cvtpk(s[2 * 33], s[3 * 33]); o.z = cvtpk(s[4 * 33], s[5 * 33]); o.w = cvtpk(s[6 * 33], s[7 * 33]);
        *(u32x4*)(WT + (size_t)(dst_row0 + n) * K + k0 + 8 * c) = o; }
    asm volatile("s_waitcnt lgkmcnt(0)" ::: "memory");
}
DI void p0_gatefold_item(const float* Win, const float* wgate, bf16_t* WT, int n0, int k0, LAS float* scr, int lane) {
    const int nn = lane & 31;
    float wg[16];
#pragma unroll
    for (int r = 0; r < 16; ++r) wg[r] = wgate[r * 256 + n0 + nn];
    for (int i = 0; i < 32; ++i) { const int kk = 2 * i + (lane >> 5); const float* src = Win + (size_t)(k0 + kk) * INCOLS + 1536; float s = 0.f;
#pragma unroll
        for (int r = 0; r < 16; ++r) s += src[r] * wg[r];
        scr[kk * 33 + nn] = s; }
    asm volatile("s_waitcnt lgkmcnt(0)" ::: "memory");
    const int c = lane & 7;
#pragma unroll
    for (int j = 0; j < 4; ++j) { const int n = (lane >> 3) + 8 * j; const LAS float* s = scr + (8 * c) * 33 + n;
        u32x4 o; o.x = cvtpk(s[0 * 33], s[1 * 33]); o.y = cvtpk(s[2 * 33], s[3 * 33]); o.z = cvtpk(s[4 * 33], s[5 * 33]); o.w = cvtpk(s[6 * 33], s[7 * 33]);
        *(u32x4*)(WT + (size_t)(PC_GL + n0 + n) * 1024 + k0 + 8 * c) = o; }
    asm volatile("s_waitcnt lgkmcnt(0)" ::: "memory");
}
DI void convert_rows(const float* X, bf16_t* XB, float* RS, int gw, int NGW, int lane) {
    for (int m0 = gw; m0 < MTOK; m0 += 2 * NGW) {
        const int m1 = m0 + NGW; const bool has1 = m1 < MTOK;
        const f32x4* xr0 = (const f32x4*)(X + (size_t)m0 * DM) + lane; const f32x4* xr1 = (const f32x4*)(X + (size_t)(has1 ? m1 : m0) * DM) + lane;
        f32x4 v0[4], v1[4];
#pragma unroll
        for (int j = 0; j < 4; ++j) { v0[j] = xr0[64 * j]; v1[j] = xr1[64 * j]; }
#pragma unroll
        for (int rr = 0; rr < 2; ++rr) { if (rr == 1 && !has1) break;
            const int m = rr ? m1 : m0;
            float s = 0.f;
#pragma unroll
            for (int j = 0; j < 4; ++j) { const f32x4 v = rr ? v1[j] : v0[j]; s += (v.x * v.x + v.y * v.y) + (v.z * v.z + v.w * v.w); }
            s = wave_sum(s); if (lane == 0) RS[m] = s;
#pragma unroll
            for (int j = 0; j < 4; ++j) { const f32x4 v = rr ? v1[j] : v0[j]; u32x2 w; w.x = cvtpk(v.x, v.y); w.y = cvtpk(v.z, v.w); st8_wt(XB, (unsigned)m * (DM * 2) + (unsigned)(lane + 64 * j) * 8u, w); } }
    }
}
DI void p1_fold_tile(bf16_t* WF, size_t bstride, int ldk, int dst_row0, int k0, int gk0, const float* nw, const float* mod_ls, float* bias, int nbias, const float* extra, LAS float* scr, int lane) {
    LAS float* G = scr + 2112; LAS float* SH = scr + 2368;
    { const int b = lane >> 4, kq = 4 * (lane & 15);
#pragma unroll
      for (int q = 0; q < 4; ++q) { const int k = gk0 + kq + q; G[b * 64 + kq + q] = nw[k] * (1.0f + mod_ls[(size_t)b * 3072 + 1024 + k]); SH[b * 64 + kq + q] = mod_ls[(size_t)b * 3072 + k]; } }
    asm volatile("s_waitcnt lgkmcnt(0)" ::: "memory");
    const int c = lane & 7;
#pragma unroll
    for (int j = 0; j < 4; ++j) { const int n = (lane >> 3) + 8 * j; const LAS float* t = scr + (8 * c) * 33 + n; float w[8];
#pragma unroll
        for (int e = 0; e < 8; ++e) w[e] = t[e * 33];
#pragma unroll
        for (int b = 0; b < 4; ++b) { const LAS float* gb = G + b * 64 + 8 * c;
            u32x4 o; o.x = cvtpk(w[0] * gb[0], w[1] * gb[1]); o.y = cvtpk(w[2] * gb[2], w[3] * gb[3]); o.z = cvtpk(w[4] * gb[4], w[5] * gb[5]); o.w = cvtpk(w[6] * gb[6], w[7] * gb[7]);
            *(u32x4*)(WF + (size_t)b * bstride + (size_t)(dst_row0 + n) * ldk + k0 + 8 * c) = o; } }
    if (bias) { const int n = lane & 31, b0 = 2 * (lane >> 5); float a0 = 0.f, a1 = 0.f;
#pragma unroll 8
      for (int kk = 0; kk < 64; ++kk) { const float w = scr[kk * 33 + n]; a0 += w * SH[b0 * 64 + kk]; a1 += w * SH[(b0 + 1) * 64 + kk]; }
      if (extra && k0 == 0) { const float ex = extra[n]; a0 += ex; a1 += ex; }
      atomicAdd(bias + (size_t)b0 * nbias + dst_row0 + n, a0); atomicAdd(bias + (size_t)(b0 + 1) * nbias + dst_row0 + n, a1); }
    asm volatile("s_waitcnt lgkmcnt(0)" ::: "memory");
}
DI void p1_fold_item(const float* W, int ldw, int src_col0, bf16_t* WF, size_t bstride, int ldk, int dst_row0, int k0, int gk0, const float* nw, const float* mod_ls, float* bias, int nbias, LAS float* scr, int lane) {
    float wv[32];
#pragma unroll
    for (int i = 0; i < 32; ++i) { const int kk = 2 * i + (lane >> 5); wv[i] = W[(size_t)(k0 + kk) * ldw + src_col0 + (lane & 31)]; }
#pragma unroll
    for (int i = 0; i < 32; ++i) { const int kk = 2 * i + (lane >> 5); scr[kk * 33 + (lane & 31)] = wv[i]; }
    p1_fold_tile(WF, bstride, ldk, dst_row0, k0, gk0, nw, mod_ls, bias, nbias, nullptr, scr, lane);
}
DI void p1_gatefold_item(const float* Win, const float* wgate, const float* bgate, bf16_t* WF, size_t bstride, int n0, int k0, const float* nw, const float* mod_ls, float* bias, int nbias, LAS float* scr, int lane) {
    const int nn = lane & 31;
    float wg[16];
#pragma unroll
    for (int r = 0; r < 16; ++r) wg[r] = wgate[r * 256 + n0 + nn];
    for (int i = 0; i < 32; ++i) { const int kk = 2 * i + (lane >> 5); const float* src = Win + (size_t)(k0 + kk) * INCOLS + 1536; float sm = 0.f;
#pragma unroll
        for (int r = 0; r < 16; ++r) sm += src[r] * wg[r];
        scr[kk * 33 + nn] = sm; }
    p1_fold_tile(WF, bstride, 1024, PC_GL + n0, k0, k0, nw, mod_ls, bias, nbias, bgate + n0, scr, lane);
}
DI void final_norm_rows(const bf16_t* X1B, const float* RS, float* OUT, const float* fw, int m_first, int m_end, int m_step, int lane) {
    const f32x4 w0 = *((const f32x4*)fw + 2 * lane), w1 = *((const f32x4*)fw + 2 * lane + 1), w2 = *((const f32x4*)(fw + 512) + 2 * lane), w3 = *((const f32x4*)(fw + 512) + 2 * lane + 1);
    for (int m = m_first; m < m_end; m += m_step) {
        const u32x4 a = *((const u32x4*)(X1B + (size_t)m * DM) + lane), c = *((const u32x4*)(X1B + (size_t)m * DM + 512) + lane);
        float ssq = 0.f;
#pragma unroll
        for (int e = 0; e < 4; ++e) { const float p0 = bflo(a[e]), p1 = bfhi(a[e]), p2 = bflo(c[e]), p3 = bfhi(c[e]); ssq += (p0 * p0 + p1 * p1) + (p2 * p2 + p3 * p3); }
        const float rstd = rsqrtf(wave_sum(ssq) * (1.f / DM) + EPS);
        f32x4* o = (f32x4*)(OUT + (size_t)m * DM) + 2 * lane;
        o[0] = (f32x4){bflo(a.x), bfhi(a.x), bflo(a.y), bfhi(a.y)} * rstd * w0; o[1] = (f32x4){bflo(a.z), bfhi(a.z), bflo(a.w), bfhi(a.w)} * rstd * w1;
        o[128] = (f32x4){bflo(c.x), bfhi(c.x), bflo(c.y), bfhi(c.y)} * rstd * w2; o[129] = (f32x4){bflo(c.z), bfhi(c.z), bflo(c.w), bfhi(c.w)} * rstd * w3;
    }
}
DI void gla_naive_rec(int wg, const bf16_t* PROJ, const float* bgate, float* OG, int tid) {
    const int b = wg >> 2, h = wg & 3, e = tid >> 2, dq = tid & 3;
    float S[16], bg[16];
#pragma unroll
    for (int i = 0; i < 16; ++i) bg[i] = bgate[h * 64 + 16 * dq + i];
#pragma unroll
    for (int i = 0; i < 16; ++i) S[i] = 0.f;
    const bf16_t* row = PROJ + (size_t)(b * SEQ) * NPROJ;
    for (int t = 0; t < SEQ; ++t, row += NPROJ) {
        const u32x4* lgp = (const u32x4*)(row + PC_GL + h * 64 + 16 * dq); const u32x4* kp = (const u32x4*)(row + PC_GK + h * 64 + 16 * dq); const u32x4* qp = (const u32x4*)(row + PC_GQ + h * 64 + 16 * dq);
        const u32x4 l0 = lgp[0], l1 = lgp[1], k0 = kp[0], k1 = kp[1], q0 = qp[0], q1 = qp[1];
        const float v = bf2f(row[PC_GV + h * 128 + e]);
        float lg[16], kk[16], qq[16];
#pragma unroll
        for (int i = 0; i < 4; ++i) { lg[2 * i] = bflo(l0[i]); lg[2 * i + 1] = bfhi(l0[i]); lg[8 + 2 * i] = bflo(l1[i]); lg[8 + 2 * i + 1] = bfhi(l1[i]);
            kk[2 * i] = bflo(k0[i]); kk[2 * i + 1] = bfhi(k0[i]); kk[8 + 2 * i] = bflo(k1[i]); kk[8 + 2 * i + 1] = bfhi(k1[i]);
            qq[2 * i] = bflo(q0[i]); qq[2 * i + 1] = bfhi(q0[i]); qq[8 + 2 * i] = bflo(q1[i]); qq[8 + 2 * i + 1] = bfhi(q1[i]); }
        float o = 0.f;
#pragma unroll
        for (int i = 0; i < 16; ++i) { const float a = __expf(logsigmoid_f(lg[i] + bg[i]) * (1.f / 16.f)); S[i] = a * S[i] + kk[i] * v; o += qq[i] * S[i]; }
        o += __shfl_xor(o, 1); o += __shfl_xor(o, 2);
        if (dq == 0) OG[(size_t)(b * SEQ + t) * 512 + h * 128 + e] = o * 0.125f;
    }
}
DI void gla_norm_gate(const float* OG, const bf16_t* PROJ, const float* gnw, bf16_t* MIX, int gw, int NGW, int lane) {
    const f32x2 g = *((const f32x2*)gnw + lane);
    for (int it = gw; it < MTOK * 4; it += NGW) {
        const int tok = it >> 2, h = it & 3;
        const f32x2 o = *((const f32x2*)(OG + (size_t)tok * 512 + h * 128) + lane);
        const float rstd = rsqrtf(wave_sum(o.x * o.x + o.y * o.y) * (1.f / 128.f) + EPS);
        const unsigned gg = *((const unsigned*)(PROJ + (size_t)tok * NPROJ + PC_GG + h * 128) + lane);
        const float y0 = o.x * rstd * g.x * silu_f(bflo(gg)), y1 = o.y * rstd * g.y * silu_f(bfhi(gg));
        *((unsigned*)(MIX + (size_t)tok * DM + h * 128) + lane) = cvtpk(y0, y1);
    }
}
DI void swa_naive(long gid, const bf16_t* PROJ, const float* rel_bias, const float* sinks, bf16_t* MIX) {
    const int t = (int)(gid & (SEQ - 1)), head = (int)((gid >> 13) & 7), b = (int)(gid >> 16), kvh = head >> 2;
    const bf16_t* base = PROJ + (size_t)(b * SEQ) * NPROJ;
    float q[64], o[64];
    { const u32x4* qp = (const u32x4*)(base + (size_t)t * NPROJ + PC_SQ + head * 64);
#pragma unroll
      for (int i = 0; i < 8; ++i) { const u32x4 w = qp[i];
#pragma unroll
          for (int j = 0; j < 4; ++j) { q[8 * i + 2 * j] = bflo(w[j]) * 0.125f; q[8 * i + 2 * j + 1] = bfhi(w[j]) * 0.125f; } } }
#pragma unroll
    for (int i = 0; i < 64; ++i) o[i] = 0.f;
    float m = sinks[head], l = 1.f;
    for (int dist = 127; dist >= 0; --dist) {
        const int tk = t - dist; if (tk < 0) continue;
        const u32x4* kp = (const u32x4*)(base + (size_t)tk * NPROJ + PC_SK + kvh * 64); const u32x4* vp = (const u32x4*)(base + (size_t)tk * NPROJ + PC_SV + kvh * 64);
        float s = 0.f;
#pragma unroll
        for (int i = 0; i < 8; ++i) { const u32x4 w = kp[i];
#pragma unroll
            for (int j = 0; j < 4; ++j) { s += q[8 * i + 2 * j] * bflo(w[j]); s += q[8 * i + 2 * j + 1] * bfhi(w[j]); } }
        s += rel_bias[T5B[dist] * 8 + head];
        const float mn = fmaxf(m, s), alpha = __expf(m - mn), p = __expf(s - mn);
        l = l * alpha + p; m = mn;
#pragma unroll
        for (int i = 0; i < 8; ++i) { const u32x4 w = vp[i];
#pragma unroll
            for (int j = 0; j < 4; ++j) { o[8 * i + 2 * j] = o[8 * i + 2 * j] * alpha + p * bflo(w[j]); o[8 * i + 2 * j + 1] = o[8 * i + 2 * j + 1] * alpha + p * bfhi(w[j]); } }
    }
    const float rl = 1.f / l;
    u32x4* op = (u32x4*)(MIX + (size_t)(b * SEQ + t) * DM + 512 + head * 64);
#pragma unroll
    for (int i = 0; i < 8; ++i) { u32x4 w;
#pragma unroll
        for (int j = 0; j < 4; ++j) w[j] = cvtpk(o[8 * i + 2 * j] * rl, o[8 * i + 2 * j + 1] * rl);
        op[i] = w; }
}
template <int W> DI void pool_run(const bf16_t* X, bf16_t* POOL, const LAS float* rsv, int grow0, int t0, int c0) {
    const int boff = grow0 * (DM * 2) + c0 * 2;
    u32x4 buf[24];
#pragma unroll
    for (int u = 0; u < 24; ++u) { const int r = grow0 + u; buf[u] = (u32x4){0u, 0u, 0u, 0u}; if (u < 8) buf[u] = *(const u32x4*)((const char*)X + (unsigned)((r < 0 ? 0 : r) * (DM * 2) + c0 * 2)); }
    f32x4 S0 = (f32x4){0.f, 0.f, 0.f, 0.f}, S1 = S0;
#pragma unroll 1
    for (int base = 0; base < 48; base += 24) {
        unsigned off = (unsigned)(boff + base * (DM * 2)); asm volatile("" : "+v"(off));
#pragma unroll
        for (int u = 0; u < 24; ++u) { const int rl = base + u;
            {
                const u32x4 nw = buf[u], od = buf[(u - W + 24) % 24];
                { const int rr = (u + 8 < 46 - base) ? u + 8 : 46 - base; const int o = (int)off + rr * (DM * 2); buf[(u + 8) % 24] = *(const u32x4*)((const char*)X + (unsigned)(o < 0 ? 0 : o)); }
                const float rn = rsv[rl], ro = -rsv[rl - W];
                const f32x4 un0 = (f32x4){bflo(nw.x), bfhi(nw.x), bflo(nw.y), bfhi(nw.y)} * rn, un1 = (f32x4){bflo(nw.z), bfhi(nw.z), bflo(nw.w), bfhi(nw.w)} * rn;
                S0 += un0; S1 += un1;
                S0 += (f32x4){bflo(od.x), bfhi(od.x), bflo(od.y), bfhi(od.y)} * ro; S1 += (f32x4){bflo(od.z), bfhi(od.z), bflo(od.w), bfhi(od.w)} * ro;
                if (rl >= 15 && rl < 47) { const int t = t0 + rl; const float ic = __builtin_amdgcn_rcpf((float)((t + 1 < W) ? t + 1 : W)); const f32x4 p0 = S0 * ic - un0, p1 = S1 * ic - un1;
                    u32x4 o; o.x = cvtpk(p0[0], p0[1]); o.y = cvtpk(p0[2], p0[3]); o.z = cvtpk(p1[0], p1[1]); o.w = cvtpk(p1[2], p1[3]);
                    *(u32x4*)((char*)POOL + (unsigned)(off + (unsigned)(u * (DM * 2)))) = o; }
                __builtin_amdgcn_sched_barrier(0);
            }
        }
    }
}
DI void pool_prelude(const pg8::StaticOrder& S, const bf16_t* X, const float* RS, bf16_t* POOL, LAS unsigned char* lds, int tid, int wave) {
    const int half = wave >> 2, ht = tid & 255, cg = ht & 31, rg = ht >> 5;
    LAS float* rsv = (LAS float*)lds + half * 320;
#pragma unroll 1
    for (int i0 = 0; ; i0 += 2) {
        pg8::Unit u0, u; if (!S.next(i0, u0)) break;
        const bool have = S.next(i0 + half, u);
        __syncthreads();
        if (have) { const int tb = (u.pm * 256) & (SEQ - 1);
            for (int j = ht; j < 288; j += 256) { const int tj = tb - 31 + j; rsv[j] = (j >= 16 && j < 287 && tj >= 0) ? rsqrtf(RS[u.pm * 256 - 31 + j] * (1.f / DM) + EPS) : 0.f; } }
        __syncthreads();
        if (have) { const int grow0 = u.pm * 256 - 15 + 32 * rg, t0 = ((u.pm * 256) & (SEQ - 1)) - 15 + 32 * rg, c0 = u.pn * 256 + 8 * cg; const LAS float* rv = rsv + 16 + 32 * rg;
            if (u.pn == 0) pool_run<2>(X, POOL, rv, grow0, t0, c0); else if (u.pn == 1) pool_run<4>(X, POOL, rv, grow0, t0, c0); else if (u.pn == 2) pool_run<8>(X, POOL, rv, grow0, t0, c0); else pool_run<16>(X, POOL, rv, grow0, t0, c0); }
    }
    asm volatile("s_waitcnt vmcnt(0)" ::: "memory");
    __syncthreads();
}

#define MFMA32(a, b, c) __builtin_amdgcn_mfma_f32_32x32x16_bf16((a), (b), (c), 0, 0, 0)
DI int crow(int reg, int hi) { return (reg & 3) + 8 * (reg >> 2) + 4 * hi; }
DI unsigned short f2bf1(float f) { return (unsigned short)(cvtpk(f, 0.f) & 0xffffu); }
#define LDS_FENCE() asm volatile("s_waitcnt lgkmcnt(0)" ::: "memory")
typedef short v4i16_t __attribute__((ext_vector_type(4)));
DI u32x2 lds_tr16(const LAS unsigned char* p) { return __builtin_bit_cast(u32x2, __builtin_amdgcn_ds_read_tr16_b64_v4i16((LAS v4i16_t*)p)); }

DI void gla_g1_item(int it, const bf16_t* PROJ, float* DS, float* DEC, LAS unsigned char* wl, int lane) {
    const int h = it & 3, n = (it >> 2) & 127, b = it >> 9, r = lane & 31, hi = lane >> 5;
    const bf16_t* base = PROJ + ((size_t)b * SEQ + (size_t)n * 64) * NPROJ;
    LAS unsigned char* ke = wl; LAS unsigned char* st = wl + 9216;
    const int lr = lane >> 3, lc = lane & 7;
    u32x4 tl[8], tk[8], tv[8];
#pragma unroll
    for (int q = 0; q < 8; ++q) { tl[q] = *(const u32x4*)(base + (size_t)(8 * q + lr) * NPROJ + PC_GL + h * 64 + lc * 8); tk[q] = *(const u32x4*)(base + (size_t)(8 * q + lr) * NPROJ + PC_GK + h * 64 + lc * 8); }
#pragma unroll
    for (int q = 0; q < 8; ++q) *(LAS u32x4*)(st + (8 * q + lr) * 144 + lc * 16) = tl[q];
#pragma unroll
    for (int q = 0; q < 8; ++q) tv[q] = *(const u32x4*)(base + (size_t)(8 * q + lr) * NPROJ + PC_GV + h * 128 + lc * 8);
    LDS_FENCE();
    float bc[64]; float run = 0.f;
#pragma unroll
    for (int i = 0; i < 64; ++i) { run += logsigmoid_f(bf2f(*(const LAS unsigned short*)(st + i * 144 + lane * 2))) * (1.f / 16.f); bc[i] = run; }
    DEC[(size_t)it * 64 + lane] = fexp(run);
    LDS_FENCE();
#pragma unroll
    for (int q = 0; q < 8; ++q) *(LAS u32x4*)(st + (8 * q + lr) * 144 + lc * 16) = tk[q];
    LDS_FENCE();
#pragma unroll
    for (int i8 = 0; i8 < 8; ++i8) { u32x4 w;
#pragma unroll
        for (int jj = 0; jj < 4; ++jj) { const int i = 8 * i8 + 2 * jj;
            const float k0 = bf2f(*(const LAS unsigned short*)(st + i * 144 + lane * 2)) * fexp(run - bc[i]), k1 = bf2f(*(const LAS unsigned short*)(st + (i + 1) * 144 + lane * 2)) * fexp(run - bc[i + 1]); w[jj] = cvtpk(k0, k1); }
        *(LAS u32x4*)(ke + lane * 144 + i8 * 16) = w; }
    bf16_t* dsb = (bf16_t*)DS + (size_t)it * 8192;
#pragma unroll 1
    for (int eh = 0; eh < 2; ++eh) {
        LDS_FENCE();
#pragma unroll
        for (int q = 0; q < 8; ++q) *(LAS u32x4*)(st + (8 * q + lr) * 144 + lc * 16) = tv[q];
        if (eh == 0) {
#pragma unroll
            for (int q = 0; q < 8; ++q) tv[q] = *(const u32x4*)(base + (size_t)(8 * q + lr) * NPROJ + PC_GV + h * 128 + 64 + lc * 8); }
        LDS_FENCE();
        f32x16 acc[2][2];
#pragma unroll
        for (int et = 0; et < 2; ++et)
#pragma unroll
            for (int dt = 0; dt < 2; ++dt)
#pragma unroll
                for (int q = 0; q < 16; ++q) acc[et][dt][q] = 0.f;
#pragma unroll
        for (int s = 0; s < 4; ++s) { bf16x8 a[2], bb[2];
#pragma unroll
            for (int t = 0; t < 2; ++t) {
                const LAS unsigned char* vr = st + (16 * s + 8 * hi + ((lane & 15) >> 2)) * 144 + (32 * t + 16 * ((lane >> 4) & 1) + 4 * (lane & 3)) * 2;
                const u32x2 lo = lds_tr16(vr), h2 = lds_tr16(vr + 4 * 144); a[t] = __builtin_bit_cast(bf16x8, (u32x4){lo.x, lo.y, h2.x, h2.y});
                bb[t] = *(const LAS bf16x8*)(ke + (32 * t + r) * 144 + (16 * s + 8 * hi) * 2); }
#pragma unroll
            for (int et = 0; et < 2; ++et)
#pragma unroll
                for (int dt = 0; dt < 2; ++dt) acc[et][dt] = MFMA32(a[et], bb[dt], acc[et][dt]); }
        LDS_FENCE();
#pragma unroll
        for (int et = 0; et < 2; ++et)
#pragma unroll
            for (int dt = 0; dt < 2; ++dt)
#pragma unroll
                for (int g4 = 0; g4 < 4; ++g4) { u32x2 w; w.x = cvtpk(acc[et][dt][4 * g4], acc[et][dt][4 * g4 + 1]); w.y = cvtpk(acc[et][dt][4 * g4 + 2], acc[et][dt][4 * g4 + 3]);
                    *(LAS u32x2*)(st + (32 * dt + r) * 144 + (32 * et + 8 * g4 + 4 * hi) * 2) = w; }
        LDS_FENCE();
#pragma unroll
        for (int q = 0; q < 8; ++q) { const u32x4 w = *(const LAS u32x4*)(st + (8 * q + lr) * 144 + lc * 16); *(u32x4*)(dsb + eh * 4096 + (8 * q + lr) * 64 + lc * 8) = w; }
    }
    LDS_FENCE();
}
DI void gla_scan(float* DSf, float* OUTf, const float* DEC, int bx, int G, int tid) {
    bf16_t* DS = (bf16_t*)DSf; bf16_t* OUT = (bf16_t*)OUTf;
    for (int idx = bx * NTHR + tid; idx < NB * 4 * 128 * 64; idx += G * NTHR) {
        const int d = (idx >> 6) & 63, h = (idx >> 13) & 3, b = idx >> 15;
        const size_t o0 = ((size_t)(b * 128) * 4 + h) * 8192 + (idx & 8191); const bf16_t* p = DS + o0; bf16_t* po = OUT + o0; const float* dp = DEC + ((size_t)(b * 128) * 4 + h) * 64 + d;
        float s = 0.f;
#pragma unroll 1
        for (int n0 = 0; n0 < 128; n0 += 16) { float ds[16], dc[16];
#pragma unroll
            for (int u = 0; u < 16; ++u) { ds[u] = bf2f(p[(size_t)(n0 + u) * 32768]); dc[u] = dp[(size_t)(n0 + u) * 256]; }
#pragma unroll
            for (int u = 0; u < 16; ++u) { po[(size_t)(n0 + u) * 32768] = f2bf1(s); s = dc[u] * s + ds[u]; } }
    }
}
constexpr int G3_QT = 0, G3_KT = 9216, G3_VT = 18432, G3_SS = 36864, G3_ST = 46080, G3_SEG = 64512, G3_PART = 65536, G3_BYTES = 77824;
#define LBAR() asm volatile("s_waitcnt lgkmcnt(0)\n\ts_barrier" ::: "memory")
DI void gla_g3_phase(const bf16_t* PROJ, const float* SIN, const float* gnw, bf16_t* MIX, LAS unsigned char* lds, int ibase, int r_, int nl, int icount, int wave, int lane) {
    const int grp = wave >> 2, w4 = wave & 3, r = lane & 31, hi = lane >> 5;
    LAS unsigned char* gl = lds + grp * G3_BYTES;
    LAS float* SEG = (LAS float*)(gl + G3_SEG); LAS float* PART = (LAS float*)(gl + G3_PART);
    const int i0 = 16 * w4;
    f32x4 gw4[4];
#pragma unroll
    for (int g = 0; g < 4; ++g) gw4[g] = *(const f32x4*)(gnw + 32 * w4 + 8 * g + 4 * hi);
    u32x4 tlg[2], tq[2], tk[2], tvv[4], sv[4]; u32x2 ggr[2][4];
#define G3_LOAD_A(ITEM) do { const int h_ = (ITEM) & 3, n_ = ((ITEM) >> 2) & 127, b_ = (ITEM) >> 9; \
        const bf16_t* base_ = PROJ + ((size_t)b_ * SEQ + (size_t)n_ * 64 + i0) * NPROJ; \
        _Pragma("unroll") for (int q = 0; q < 2; ++q) { const bf16_t* rp_ = base_ + (size_t)(8 * q + (lane >> 3)) * NPROJ + h_ * 64 + (lane & 7) * 8; \
            tlg[q] = *(const u32x4*)(rp_ + PC_GL); tq[q] = *(const u32x4*)(rp_ + PC_GQ); tk[q] = *(const u32x4*)(rp_ + PC_GK); } \
        _Pragma("unroll") for (int q = 0; q < 4; ++q) tvv[q] = *(const u32x4*)(base_ + (size_t)(4 * q + (lane >> 4)) * NPROJ + PC_GV + h_ * 128 + (lane & 15) * 8); } while (0)
    { const int it0 = r_ * 2 + grp; if (it0 < icount) G3_LOAD_A(ibase + it0); }
    for (int rnd = 0; rnd * nl * 2 < icount; ++rnd) {
        const int li = (rnd * nl + r_) * 2 + grp, item = ibase + li; const bool valid = li < icount;
        const int nli = ((rnd + 1) * nl + r_) * 2 + grp, nitem = ibase + nli; const bool nvalid = nli < icount;
        const int h = item & 3, n = (item >> 2) & 127, b = item >> 9;
        const size_t row0 = (size_t)b * SEQ + (size_t)n * 64;
        float la[16];
        if (valid) {
            { const bf16_t* sp_ = (const bf16_t*)SIN + (size_t)item * 8192 + (16 * w4 + (lane >> 2)) * 64 + 8 * (lane & 3);
#pragma unroll
              for (int k = 0; k < 4; ++k) sv[k] = *(const u32x4*)(sp_ + (k >> 1) * 4096 + (k & 1) * 32); }
#pragma unroll
            for (int it = 0; it < 2; ++it)
#pragma unroll
                for (int g = 0; g < 4; ++g) ggr[it][g] = *(const u32x2*)(PROJ + (row0 + 32 * it + r) * NPROJ + PC_GG + h * 128 + 32 * w4 + 8 * g + 4 * hi);
#pragma unroll
            for (int q = 0; q < 2; ++q) { const int ro = (i0 + 8 * q + (lane >> 3)) * 144 + (lane & 7) * 16;
                *(LAS u32x4*)(gl + G3_SS + ro) = tlg[q]; *(LAS u32x4*)(gl + G3_QT + ro) = tq[q]; *(LAS u32x4*)(gl + G3_KT + ro) = tk[q]; }
#pragma unroll
            for (int q = 0; q < 4; ++q) *(LAS u32x4*)(gl + G3_VT + (i0 + 4 * q + (lane >> 4)) * 272 + (lane & 15) * 16) = tvv[q];
            LDS_FENCE();
            float run = 0.f;
#pragma unroll
            for (int i = 0; i < 16; ++i) { run += logsigmoid_f(bf2f(*(const LAS unsigned short*)(gl + G3_SS + (i0 + i) * 144 + lane * 2))) * (1.f / 16.f); la[i] = run; }
            SEG[w4 * 64 + lane] = run;
        }
        LBAR();
        if (valid) {
            float pre = 0.f;
#pragma unroll
            for (int w = 0; w < 3; ++w) if (w < w4) pre += SEG[w * 64 + lane];
#pragma unroll
            for (int i = 0; i < 16; ++i) { const float bi = pre + la[i];
                LAS unsigned short* qp = (LAS unsigned short*)(gl + G3_QT + (i0 + i) * 144 + lane * 2); LAS unsigned short* kp = (LAS unsigned short*)(gl + G3_KT + (i0 + i) * 144 + lane * 2);
                const float qv = bf2f(*qp), kv = bf2f(*kp);
                *qp = f2bf1(qv * 0.125f * fexp(bi)); *kp = f2bf1(kv * fexp(-bi)); }
#pragma unroll
            for (int k = 0; k < 4; ++k) { const int e0 = 8 * ((lane & 3) + 4 * k), dd = 16 * w4 + (lane >> 2);
#pragma unroll
                for (int j = 0; j < 4; ++j) { *(LAS unsigned short*)(gl + G3_ST + (e0 + 2 * j) * 144 + dd * 2) = (unsigned short)(sv[k][j] & 0xffffu); *(LAS unsigned short*)(gl + G3_ST + (e0 + 2 * j + 1) * 144 + dd * 2) = (unsigned short)(sv[k][j] >> 16); } }
        }
        if (nvalid) G3_LOAD_A(nitem);
        LBAR();
        if (valid) {
            const int jt = w4 >> 1, it = w4 & 1;
            f32x16 acc;
#pragma unroll
            for (int q = 0; q < 16; ++q) acc[q] = 0.f;
            if (!(jt == 1 && it == 0)) {
#pragma unroll
                for (int s = 0; s < 4; ++s) { const bf16x8 a = *(const LAS bf16x8*)(gl + G3_KT + (32 * jt + r) * 144 + (16 * s + 8 * hi) * 2); const bf16x8 bq = *(const LAS bf16x8*)(gl + G3_QT + (32 * it + r) * 144 + (16 * s + 8 * hi) * 2);
                    acc = MFMA32(a, bq, acc); } }
    #pragma unroll
            for (int g = 0; g < 4; ++g) { float v[4];
#pragma unroll
                for (int k = 0; k < 4; ++k) { const int j = 32 * jt + 8 * g + 4 * hi + k, i = 32 * it + r; v[k] = (j <= i) ? acc[4 * g + k] : 0.f; }
                u32x2 w; w.x = cvtpk(v[0], v[1]); w.y = cvtpk(v[2], v[3]);
                *(LAS u32x2*)(gl + G3_SS + (32 * it + r) * 144 + (32 * jt + 8 * g + 4 * hi) * 2) = w; }
        }
        LBAR();
        f32x16 oacc[2];
        if (valid) {
#pragma unroll
            for (int it = 0; it < 2; ++it) {
#pragma unroll
                for (int q = 0; q < 16; ++q) oacc[it][q] = 0.f;
#pragma unroll
                for (int s = 0; s < 4; ++s) { if (it == 0 && s >= 2) continue;
                    const LAS unsigned char* vr = gl + G3_VT + (16 * s + 8 * hi + ((lane & 15) >> 2)) * 272 + (32 * w4 + 16 * ((lane >> 4) & 1) + 4 * (lane & 3)) * 2;
                    const u32x2 lo = lds_tr16(vr), h2 = lds_tr16(vr + 4 * 272); const bf16x8 a = __builtin_bit_cast(bf16x8, (u32x4){lo.x, lo.y, h2.x, h2.y});
                    const bf16x8 bs = *(const LAS bf16x8*)(gl + G3_SS + (32 * it + r) * 144 + (16 * s + 8 * hi) * 2);
                    oacc[it] = MFMA32(a, bs, oacc[it]); }
#pragma unroll
                for (int s = 0; s < 4; ++s) { const bf16x8 a = *(const LAS bf16x8*)(gl + G3_ST + (32 * w4 + r) * 144 + (16 * s + 8 * hi) * 2); const bf16x8 bq = *(const LAS bf16x8*)(gl + G3_QT + (32 * it + r) * 144 + (16 * s + 8 * hi) * 2);
                    oacc[it] = MFMA32(a, bq, oacc[it]); }
                float ss = 0.f;
#pragma unroll
                for (int q = 0; q < 16; ++q) ss += oacc[it][q] * oacc[it][q];
                ss += __shfl_xor(ss, 32);
                if (hi == 0) PART[w4 * 64 + 32 * it + r] = ss;
            }
        }
        LBAR();
        if (valid) {
#pragma unroll
            for (int it = 0; it < 2; ++it) { const int i = 32 * it + r;
                const float tot = (PART[i] + PART[64 + i]) + (PART[128 + i] + PART[192 + i]); const float rstd = rsqrtf(tot * (1.f / 128.f) + EPS);
#pragma unroll
                for (int g = 0; g < 4; ++g) { const int e0 = 32 * w4 + 8 * g + 4 * hi; const u32x2 gg = ggr[it][g];
                    const float y0 = oacc[it][4 * g + 0] * rstd * gw4[g][0] * silu_f(bflo(gg.x)), y1 = oacc[it][4 * g + 1] * rstd * gw4[g][1] * silu_f(bfhi(gg.x));
                    const float y2 = oacc[it][4 * g + 2] * rstd * gw4[g][2] * silu_f(bflo(gg.y)), y3 = oacc[it][4 * g + 3] * rstd * gw4[g][3] * silu_f(bfhi(gg.y));
                    u32x2 w; w.x = cvtpk(y0, y1); w.y = cvtpk(y2, y3); *(LAS u32x2*)(gl + G3_ST + i * 272 + e0 * 2) = w; } }
        }
        LBAR();
        if (valid) {
#pragma unroll
            for (int q = 0; q < 4; ++q) { const int row = i0 + 4 * q + (lane >> 4), ch = lane & 15; const u32x4 w = *(const LAS u32x4*)(gl + G3_ST + row * 272 + ch * 16);
                *(u32x4*)(MIX + (row0 + row) * DM + h * 128 + ch * 8) = w; }
        }
    }
#undef G3_LOAD_A
    __syncthreads();
}
constexpr int SW_KS = 0, SW_VT = 36864, SW_BIAS = 73728, SW_OST = 75776;

DI void swa_item(int item, const bf16_t* PROJ, const float* rel_bias, const float* sinks, bf16_t* MIX, LAS unsigned char* lds, int tid, int wave, int lane) {
    const int kvh = item & 1, blk = (item >> 1) & 63, b = item >> 7, r = lane & 31, hi = lane >> 5;
    const bf16_t* pb = PROJ + (size_t)b * SEQ * NPROJ;
    LAS float* BIAS = (LAS float*)(lds + SW_BIAS);
    for (int c = tid; c < 2048; c += NTHR) { const int kj = c >> 3, ch = c & 7, trow = (blk - 1) * 128 + kj; u32x4 w = (u32x4){0u, 0u, 0u, 0u};
        if (trow >= 0) w = *(const u32x4*)(pb + (size_t)trow * NPROJ + PC_SK + kvh * 64 + ch * 8);
        *(LAS u32x4*)(lds + SW_KS + kj * 144 + ch * 16) = w; }
    for (int c = tid; c < 2048; c += NTHR) { const int kj = c >> 3, ch = c & 7, trow = (blk - 1) * 128 + kj; u32x4 w = (u32x4){0u, 0u, 0u, 0u};
        if (trow >= 0) w = *(const u32x4*)(pb + (size_t)trow * NPROJ + PC_SV + kvh * 64 + ch * 8);
        *(LAS u32x4*)(lds + SW_VT + kj * 144 + ch * 16) = w; }
    { const int g = tid >> 7, dist = tid & 127; BIAS[tid] = rel_bias[T5B[dist] * 8 + kvh * 4 + g]; }
    __syncthreads();
#pragma unroll 1
    for (int uu = 0; uu < 2; ++uu) {
        const int u = 2 * wave + uu, g = u >> 2, qt = u & 3, head = kvh * 4 + g;
        const size_t qrow = (size_t)b * SEQ + blk * 128 + 32 * qt + r;
        bf16x8 qf[4];
#pragma unroll
        for (int s = 0; s < 4; ++s) qf[s] = *(const bf16x8*)(PROJ + qrow * NPROJ + PC_SQ + head * 64 + 16 * s + 8 * hi);
        f32x16 S[5];
#pragma unroll
        for (int t = 0; t < 5; ++t) {
#pragma unroll
            for (int q = 0; q < 16; ++q) S[t][q] = 0.f;
#pragma unroll
            for (int s = 0; s < 4; ++s) { const bf16x8 a = *(const LAS bf16x8*)(lds + SW_KS + (32 * (qt + t) + r) * 144 + (16 * s + 8 * hi) * 2); S[t] = MFMA32(a, qf[s], S[t]); } }
        const float sink = sinks[head]; float m = sink;
#pragma unroll
        for (int t = 0; t < 5; ++t)
#pragma unroll
            for (int q = 0; q < 16; ++q) { const int kr = crow(q, hi), dist = 128 + r - kr - 32 * t; const bool ok = (dist >= 0) && (dist < 128) && (blk > 0 || 32 * (qt + t) + kr >= 128);
                const float sv = ok ? S[t][q] * 0.125f + BIAS[g * 128 + (dist & 127)] : -1e30f; S[t][q] = sv; m = fmaxf(m, sv); }
        m = fmaxf(m, __shfl_xor(m, 32));
        float l = 0.f;
#pragma unroll
        for (int t = 0; t < 5; ++t)
#pragma unroll
            for (int q = 0; q < 16; ++q) { const float p = fexp(S[t][q] - m); S[t][q] = p; l += p; }
        l += __shfl_xor(l, 32); l += fexp(sink - m);
        f32x16 O[2];
#pragma unroll
        for (int dt = 0; dt < 2; ++dt)
#pragma unroll
            for (int q = 0; q < 16; ++q) O[dt][q] = 0.f;
#pragma unroll
        for (int t = 0; t < 5; ++t)
#pragma unroll
            for (int s2 = 0; s2 < 2; ++s2) { u32x4 pw;
#pragma unroll
                for (int jj = 0; jj < 4; ++jj) pw[jj] = cvtpk(S[t][8 * s2 + 2 * jj], S[t][8 * s2 + 2 * jj + 1]);
                const bf16x8 pf = __builtin_bit_cast(bf16x8, pw);
#pragma unroll
                for (int dt = 0; dt < 2; ++dt) {
                    const LAS unsigned char* vr = lds + SW_VT + (32 * (qt + t) + 16 * s2 + 4 * hi + ((lane & 15) >> 2)) * 144 + (32 * dt + 16 * ((lane >> 4) & 1) + 4 * (lane & 3)) * 2;
                    const u32x2 lo = lds_tr16(vr), h2 = lds_tr16(vr + 8 * 144); const u32x4 av = (u32x4){lo.x, lo.y, h2.x, h2.y};
                    O[dt] = MFMA32(__builtin_bit_cast(bf16x8, av), pf, O[dt]); } }
        const float rl = 1.f / l;
        LAS unsigned char* og = lds + SW_OST + wave * 4608;
#pragma unroll
        for (int dt = 0; dt < 2; ++dt)
#pragma unroll
            for (int g4 = 0; g4 < 4; ++g4) { u32x2 w; w.x = cvtpk(O[dt][4 * g4] * rl, O[dt][4 * g4 + 1] * rl); w.y = cvtpk(O[dt][4 * g4 + 2] * rl, O[dt][4 * g4 + 3] * rl);
                *(LAS u32x2*)(og + r * 144 + (32 * dt + 8 * g4 + 4 * hi) * 2) = w; }
        LDS_FENCE();
#pragma unroll
        for (int q4 = 0; q4 < 4; ++q4) { const int row = 8 * q4 + (lane >> 3), ch = lane & 7; const u32x4 w = *(const LAS u32x4*)(og + row * 144 + ch * 16);
            *(u32x4*)(MIX + ((size_t)b * SEQ + blk * 128 + 32 * qt + row) * DM + 512 + head * 64 + ch * 8) = w; }
        LDS_FENCE();
    }
    __syncthreads();
}

DI void stagger_start(int bx, int ticks) {
    const int q = ((bx >> 3) & 7) >> 1;
    if (q) { const unsigned long long t0 = __builtin_amdgcn_s_memrealtime(); while (__builtin_amdgcn_s_memrealtime() - t0 < (unsigned long long)(q * ticks)) __builtin_amdgcn_s_sleep(8); }
}
struct Args { const float* in[17]; float* out; unsigned char* ws; int ph_lo, ph_hi, use_bar, pad; };
enum { I_X = 0, I_C, I_NORMW, I_ADAW, I_ADAB, I_WIN, I_WGATE, I_BGATE, I_GNW, I_SINKS, I_WOUT, I_RELB, I_POOLW, I_POOLS, I_W1, I_W2, I_FNW };
constexpr int NPHASE = 16;
constexpr int STAG1 = 450;
__device__ const int REPS[16] = {1, 1, 1, 1, 1, 1, 1, 1, 1, 1, 1, 1, 1, 1, 1, 1};

__global__ void __launch_bounds__(NTHR, 2) mk_fwd(Args args) {
    extern __shared__ __attribute__((aligned(16))) unsigned char lds_raw[];
    LAS unsigned char* lds = (LAS unsigned char*)lds_raw;
    volatile LAS unsigned* MISC = (volatile LAS unsigned*)(lds + MISC_OFF);
    const int wave = __builtin_amdgcn_readfirstlane((int)threadIdx.x >> 6);
    const int G = gridDim.x, bx = blockIdx.x;
    const int vcu = (G % 8 == 0) ? (bx % 8) * (G / 8) + bx / 8 : bx;
    const int gw = vcu * NWAVES + wave, NGW = G * NWAVES;
    unsigned char* ws = args.ws;
    unsigned* ctl = (unsigned*)(ws + WS_CTL);
    float* MOD = (float*)(ws + WS_MOD);
    bf16_t* WIN_T = (bf16_t*)(ws + WS_WIN); bf16_t* WOUT_T = (bf16_t*)(ws + WS_WOUT); bf16_t* W1_T = (bf16_t*)(ws + WS_W1); bf16_t* W2_T = (bf16_t*)(ws + WS_W2); bf16_t* WP_T = (bf16_t*)(ws + WS_WP);
    bf16_t* H = (bf16_t*)(ws + WS_H); bf16_t* PROJ = (bf16_t*)(ws + WS_PROJ); bf16_t* MIX = (bf16_t*)(ws + WS_MIX); bf16_t* HID = (bf16_t*)(ws + WS_HID); bf16_t* POOL = (bf16_t*)(ws + WS_POOL); bf16_t* X2B = POOL; bf16_t* WPF = (bf16_t*)(ws + WS_WPF);
    float* DS = (float*)(ws + WS_DS); float* DEC = (float*)(ws + WS_DEC); float* BIAS = (float*)(ctl + CW_BIAS); float* RS = (float*)(ctl + CW_RS); bf16_t* X1B = (bf16_t*)(ws + WS_X1B); bf16_t* WINF = (bf16_t*)(ws + WS_WINF); bf16_t* W1F0 = (bf16_t*)(ws + WS_W1F0); bf16_t* W1F1 = (bf16_t*)(ws + WS_W1F1);
    const float* x = args.in[I_X];

    if (wave == 0) MISC[lane_id()] = 0u;
    __syncthreads();
    XcdBarrier bar; bar.bar = ctl + CW_BAR; bar.x = 0; bar.st = nullptr; bar.wave = wave;
    if (args.use_bar) bar = xcd_barrier_post(ctl + CW_BAR, MISC + 8, wave);
    const int lo = args.ph_lo, hi = args.ph_hi;
#define IN(k) (lo <= (k) && (k) < hi)
#define SEAM(k) do { if (IN(k) && (k) + 1 < hi) xcd_barrier(bar); } while (0)
#define RL(k) _Pragma("unroll 1") for (int rep = 0; rep < REPS[k]; ++rep)
    const float* ZEROS = (const float*)(ctl + CW_ZEROS);

    if (IN(0)) RL(0) {
        for (int un = bx; un < 256; un += G) p0_mod_unit(un, args.in[I_C], args.in[I_ADAW], args.in[I_ADAB], MOD, lds, fresh_tid(wave), wave, (fresh_tid(wave) & 63));
        LAS float* scr = (LAS float*)(lds + wave * 16384);
        constexpr int I_OUT = 16 * 32, I_2 = 64 * 32;
        constexpr int NITEMS = I_OUT + 2 * I_2;
        for (int it = gw; it < NITEMS; it += NGW) {
            int r = it;
            if (r < I_OUT) { const int kb = r / 32, nb = r % 32; p0_transpose_item(args.in[I_WOUT], 1024, nb * 32, WOUT_T, 1024, nb * 32, kb * 64, scr, (fresh_tid(wave) & 63)); continue; } r -= I_OUT;
            { const int l = r / I_2; r -= l * I_2; const int kb = r / 32, nb = r % 32; p0_transpose_item(args.in[I_W2] + (size_t)l * 4096 * 1024, 1024, nb * 32, W2_T + (size_t)l * 1024 * 4096, 4096, nb * 32, kb * 64, scr, (fresh_tid(wave) & 63)); }
        }
        __syncthreads();
    }
    SEAM(0);
    const int uni = args.use_bar ? __builtin_amdgcn_readfirstlane((int)MISC[11]) : 0;
    const int xr = __builtin_amdgcn_readfirstlane((int)MISC[10]), xcd = (int)bar.x;
    const int cid = uni ? xr * 8 + xcd : bx;
    const int vcu2 = uni ? xcd * 32 + xr : vcu;
    const int gw2 = vcu2 * NWAVES + wave;
#define SEAM_L(k) do { if (IN(k) && (k) + 1 < hi) xcd_barrier(bar, uni); } while (0)
    if (IN(1)) RL(1) {
        LAS float* scr = (LAS float*)(lds + wave * 16384);
        float* BIASw = rep ? (float*)(ws + WS_W1) : BIAS;
        constexpr int J_IN = 16 * 72, J_GF = 16 * 8, J_1 = 16 * 128, J_P = 4 * 32;
        for (int it = gw2; it < J_IN + J_GF + 2 * J_1 + J_P; it += NGW) {
            int r = it; const int ln = (fresh_tid(wave) & 63);
            if (r < J_IN) { const int kb = r / 72, nb = r % 72, n0 = nb * 32; p1_fold_item(args.in[I_WIN], INCOLS, n0 < 1536 ? n0 : n0 + 16, WINF, (size_t)NPROJ * 1024, 1024, n0, kb * 64, kb * 64, args.in[I_NORMW], MOD, BIASw, NPROJ, scr, ln); continue; } r -= J_IN;
            if (r < J_GF) { const int kb = r / 8, nb = r % 8; p1_gatefold_item(args.in[I_WIN], args.in[I_WGATE], args.in[I_BGATE], WINF, (size_t)NPROJ * 1024, nb * 32, kb * 64, args.in[I_NORMW], MOD, BIASw, NPROJ, scr, ln); continue; } r -= J_GF;
            if (r >= 2 * J_1) { r -= 2 * J_1; const int gi = r / 32; r -= gi * 32; const int kb = r / 8, nb = r % 8;
              p1_fold_item(args.in[I_POOLW] + (size_t)gi * 65536, 256, nb * 32, WPF, (size_t)1024 * 256, 256, 256 * gi + nb * 32, kb * 64, 256 * gi + kb * 64, args.in[I_NORMW] + 2 * 1024, MOD + (size_t)2 * 4 * 3072, nullptr, 0, scr, ln); continue; }
            { const int l = r / J_1; r -= l * J_1; const int kb = r / 128, nb = r % 128; const int ls = 2 * l + 1;
              p1_fold_item(args.in[I_W1] + (size_t)l * 1024 * 4096, 4096, nb * 32, l ? W1F1 : W1F0, (size_t)FF * 1024, 1024, nb * 32, kb * 64, kb * 64, args.in[I_NORMW] + ls * 1024, MOD + (size_t)ls * 4 * 3072, BIASw + 4 * NPROJ + (size_t)l * 4 * FF, FF, scr, ln); }
        }
        convert_rows(x, X1B, RS + 0 * MTOK, gw2, NGW, (fresh_tid(wave) & 63));
    }
    SEAM(1);
    if (IN(2)) { pg8::Gemm g{X1B, WINF, 1024, 1024, 1024, 0, (size_t)NPROJ * 1024}; pg8::StaticOrder S; S.init(MTOK, NPROJ, G, cid, REPS[2]);
        pg8::EpiBf16<0> E{PROJ, NPROJ, RS + 0 * MTOK, BIAS, NPROJ}; pg8::gemm_phase<pg8::EpiBf16<0>, true, true>(lds, g, S, E, wave); }
    SEAM(2);
    if (IN(3)) {
        RL(3) { for (int it = gw2; it < 2048; it += NGW) gla_g1_item(it, PROJ, DS, DEC, lds + wave * 18432, (fresh_tid(wave) & 63));
            __syncthreads(); }
        RL(7) { for (int it = bx; it < 512; it += G) swa_item(it, PROJ, args.in[I_RELB], args.in[I_SINKS], MIX, lds, fresh_tid(wave), wave, (fresh_tid(wave) & 63)); }
    }
    SEAM(3);
    if (IN(4)) RL(4) gla_scan(DS, rep + 1 < REPS[4] ? args.out : DS, DEC, bx, G, fresh_tid(wave));
    SEAM(4);
    if (IN(5)) RL(5) gla_g3_phase(PROJ, DS, args.in[I_GNW], MIX, lds, uni ? 256 * xcd : 0, uni ? xr : bx, uni ? 32 : G, uni ? 256 : 2048, wave, (fresh_tid(wave) & 63));
    SEAM_L(5);
    if (IN(6)) { pg8::Gemm g{MIX, WOUT_T, 1024, 1024, 1024, 0}; pg8::StaticOrder S; S.init(MTOK, DM, G, cid, REPS[6]);
        pg8::EpiRes<false, false> E{X1B, X1B, nullptr, MOD + 0 * 4 * 3072, nullptr, nullptr, nullptr, RS + 1 * MTOK, ZEROS}; pg8::gemm_phase<pg8::EpiRes<false, false>, true, true>(lds, g, S, E, wave); }
    SEAM(6);
    if (IN(8)) { pg8::Gemm g{X1B, W1F0, 1024, 1024, 1024, 0, (size_t)FF * 1024}; pg8::StaticOrder S; S.init(MTOK, FF, G, cid, REPS[8]);
        pg8::EpiBf16<2> E{HID, HIDLD, RS + 1 * MTOK, BIAS + 4 * 2560, FF}; pg8::gemm_phase<pg8::EpiBf16<2>, true, true>(lds, g, S, E, wave); }
    SEAM_L(8);
    if (IN(9)) { pg8::Gemm g{HID, W2_T, HIDLD, 4096, 4096, 0}; pg8::StaticOrder S; S.init(MTOK, DM, G, cid, REPS[9]);
        pg8::EpiRes<false, false> E{X1B, X1B, nullptr, MOD + 1 * 4 * 3072, nullptr, nullptr, nullptr, RS + 2 * MTOK, ZEROS}; pg8::gemm_phase<pg8::EpiRes<false, false>, true, true>(lds, g, S, E, wave); }
    SEAM(9);
    if (IN(10) || IN(11)) { pg8::StaticOrder Sp; Sp.init(MTOK, DM, G, cid, 1);
        if (IN(10)) RL(10) pool_prelude(Sp, X1B, RS + 2 * MTOK, POOL, lds, fresh_tid(wave), wave); }
    if (IN(11)) { pg8::Gemm g{POOL, WPF, 1024, 256, 256, 256, (size_t)1024 * 256}; pg8::StaticOrder S; S.init(MTOK, DM, G, cid, REPS[11]);
        pg8::EpiRes<false, false> E{X1B, X2B, nullptr, MOD + 2 * 4 * 3072, args.in[I_POOLS], nullptr, nullptr, RS + 3 * MTOK, ZEROS}; pg8::gemm_phase<pg8::EpiRes<false, false>, true, true>(lds, g, S, E, wave); }
    SEAM_L(11);
    if (IN(13)) { pg8::Gemm g{X2B, W1F1, 1024, 1024, 1024, 0, (size_t)FF * 1024}; pg8::StaticOrder S; S.init(MTOK, FF, G, cid, REPS[13]);
        pg8::EpiBf16<2> E{HID, HIDLD, RS + 3 * MTOK, BIAS + 4 * 2560 + 4 * 4096, FF}; pg8::gemm_phase<pg8::EpiBf16<2>, true, true>(lds, g, S, E, wave); }
    SEAM_L(13);
    if (IN(14)) { pg8::Gemm g{HID, W2_T + (size_t)1024 * 4096, HIDLD, 4096, 4096, 0}; pg8::StaticOrder S; S.init(MTOK, DM, G, cid, REPS[14]);
        pg8::EpiRes<false, false> E{X2B, X2B, nullptr, MOD + 3 * 4 * 3072, nullptr, nullptr, nullptr, nullptr, ZEROS}; pg8::gemm_phase<pg8::EpiRes<false, false>, true, true>(lds, g, S, E, wave); }
    SEAM_L(14);
    if (IN(15)) RL(15) final_norm_rows(X2B, RS + 4 * MTOK, args.out, args.in[I_FNW], uni ? 4096 * xcd + xr * NWAVES + wave : gw2, uni ? 4096 * xcd + 4096 : MTOK, uni ? 256 : NGW, (fresh_tid(wave) & 63));
#undef IN
#undef SEAM
#undef SEAM_L
#undef RL
}

#ifndef MK_N_LAUNCHES
#define MK_N_LAUNCHES 1
#endif
extern "C" void kernel_launch(void* const* d_in, const int* in_sizes, int n_in, void* d_out, int out_size, void* d_ws, size_t ws_size, hipStream_t stream) {
    static int grid = 0;
    if (grid == 0) {
        if (n_in != 17 || in_sizes[0] != MTOK * DM || out_size != MTOK * DM || ws_size < WS_END) { fprintf(stderr, "kernel_launch: unexpected shapes (n_in %d, in0 %d, out %d, ws %zu)\n", n_in, n_in > 0 ? in_sizes[0] : -1, out_size, ws_size); grid = -1; return; }
        int dev = 0, cus = 0, per_cu = 0;
        if (hipGetDevice(&dev) != hipSuccess || hipDeviceGetAttribute(&cus, hipDeviceAttributeMultiprocessorCount, dev) != hipSuccess) { grid = -1; return; }
        if (hipFuncSetAttribute((const void*)mk_fwd, hipFuncAttributeMaxDynamicSharedMemorySize, LDS_BYTES) != hipSuccess) { fprintf(stderr, "kernel_launch: hipFuncSetAttribute failed\n"); grid = -1; return; }
        if (hipOccupancyMaxActiveBlocksPerMultiprocessor(&per_cu, (const void*)mk_fwd, NTHR, LDS_BYTES) != hipSuccess || per_cu < 1) { fprintf(stderr, "kernel_launch: occupancy query says %d\n", per_cu); per_cu = 1; }
        (void)hipGetLastError();
        grid = cus;
    }
    if (grid < 0) return;
    (void)hipMemsetAsync((char*)d_ws + WS_CTL, 0, CTL_ZERO_BYTES, stream);
    Args a{};
    for (int i = 0; i < 17; ++i) a.in[i] = (const float*)d_in[i];
    a.out = (float*)d_out; a.ws = (unsigned char*)d_ws;
#if MK_N_LAUNCHES == 1
    a.ph_lo = 0; a.ph_hi = NPHASE; a.use_bar = 1;
    void* kargs[] = {&a};
    hipError_t e = hipLaunchCooperativeKernel((const void*)mk_fwd, dim3(grid), dim3(NTHR), kargs, LDS_BYTES, stream);
    if (e != hipSuccess) fprintf(stderr, "kernel_launch: cooperative launch failed: %s\n", hipGetErrorString(e));
#else
    for (int p = 0; p < NPHASE; ++p) { if (p == 7 || p == 12) continue; a.ph_lo = p; a.ph_hi = p + 1; a.use_bar = 0;
        hipLaunchKernelGGL(mk_fwd, dim3(grid), dim3(NTHR), LDS_BYTES, stream, a); }
#endif
}
```

```cpp
#include <hip/hip_runtime.h>
#include <cstdio>
#include <cstdint>

#define LAS __attribute__((address_space(3)))
typedef unsigned short bf16_t;
typedef short bf16x8 __attribute__((ext_vector_type(8)));
typedef float f32x4 __attribute__((ext_vector_type(4)));
typedef float f32x2 __attribute__((ext_vector_type(2)));
typedef float f32x16 __attribute__((ext_vector_type(16)));
typedef unsigned u32x4 __attribute__((ext_vector_type(4)));
typedef unsigned u32x2 __attribute__((ext_vector_type(2)));
typedef __bf16 bf16x2_t __attribute__((ext_vector_type(2)));
#define DI __device__ __forceinline__

constexpr int NB = 4, SEQ = 8192, DM = 1024, MTOK = NB * SEQ, FF = 4096, NPROJ = 2560, INCOLS = 2320;
constexpr int PC_GQ = 0, PC_GK = 256, PC_GV = 512, PC_GG = 1024, PC_SQ = 1536, PC_SK = 2048, PC_SV = 2176, PC_GL = 2304;
constexpr float EPS = 1e-6f;
__device__ __forceinline__ size_t proj_off(size_t row, int col) { return ((row >> 8) * (size_t)(NPROJ / 64) + (size_t)(col >> 6)) * 16384 + (row & 255) * 64 + (size_t)(col & 63); }
constexpr int NWAVES = 8, NTHR = 512;
constexpr int HIDLD = 4160;

constexpr size_t MiB = 1u << 20;
constexpr size_t WS_CTL = 0, CTL_ZERO_BYTES = 2 * MiB;
constexpr size_t WS_MOD = 2 * MiB;
constexpr size_t WS_BIAS = 2 * MiB + 512 * 1024;
constexpr size_t WS_WIN = 3 * MiB;
constexpr size_t WS_WOUT = 8 * MiB;
constexpr size_t WS_W1 = 10 * MiB;
constexpr size_t WS_W2 = 26 * MiB;
constexpr size_t WS_WP = 42 * MiB;
constexpr size_t WS_DEC = 43 * MiB;
constexpr size_t WS_H = 48 * MiB;
constexpr size_t WS_PROJ = 112 * MiB;
constexpr size_t WS_MIX = 272 * MiB;
constexpr size_t WS_DS = 336 * MiB;
constexpr size_t WS_HID = 112 * MiB;
constexpr size_t WS_POOL = 48 * MiB;
constexpr size_t WS_X1B = 400 * MiB;
constexpr size_t WS_WINF = 80 * MiB;
constexpr size_t WS_W1F0 = 48 * MiB;
constexpr size_t WS_W1F1 = 464 * MiB;
constexpr size_t WS_WPF = 44 * MiB;
constexpr size_t WS_END = 496 * MiB;
constexpr int CW_ZEROS = 65536;
constexpr int CW_BIAS = 327680;
constexpr int CW_RS = 131072;
constexpr int CW_BAR = 4096;

constexpr int RING_BYTES = 155648;
constexpr int MISC_OFF = RING_BYTES;
constexpr int LDS_BYTES = 163840;

DI unsigned cvtpk(float lo, float hi) { f32x2 v = {lo, hi}; bf16x2_t b = __builtin_convertvector(v, bf16x2_t); return __builtin_bit_cast(unsigned, b); }
DI void st16_wt(void* base  , unsigned byte_off, u32x4 v) { asm volatile("s_nop 4\n\tglobal_store_dwordx4 %0, %1, %2 sc1\n\ts_nop 1" :: "v"(byte_off), "v"(v), "s"(base) : "memory"); }
DI int lane_id() { return (int)__builtin_amdgcn_mbcnt_hi(~0u, __builtin_amdgcn_mbcnt_lo(~0u, 0u)); }
DI int fresh_tid(int wave) { return wave * 64 + lane_id(); }
DI int opaque_lane() { unsigned m = ~0u; asm volatile("" : "+s"(m)); return (int)__builtin_amdgcn_mbcnt_hi(m, __builtin_amdgcn_mbcnt_lo(m, 0u)); }
DI void st8_wt(void* base  , unsigned byte_off, u32x2 v) { asm volatile("s_nop 4\n\tglobal_store_dwordx2 %0, %1, %2 sc1\n\ts_nop 1" :: "v"(byte_off), "v"(v), "s"(base) : "memory"); }
DI float bflo(unsigned w) { return __uint_as_float(w << 16); }
DI float bfhi(unsigned w) { return __uint_as_float(w & 0xffff0000u); }
DI float bf2f(bf16_t u) { return __uint_as_float((unsigned)u << 16); }
DI float wave_sum(float v) {
#pragma unroll
    for (int o = 1; o < 64; o <<= 1) v += __shfl_xor(v, o);
    return v;
}
DI float fexp(float x) { return __builtin_amdgcn_exp2f(x * 1.4426950408889634f); }
DI float flog(float x) { return __builtin_amdgcn_logf(x) * 0.6931471805599453f; }
DI float silu_f(float x) { return x * __builtin_amdgcn_rcpf(1.f + fexp(-x)); }
DI float logsigmoid_f(float x) { return fminf(x, 0.f) - flog(1.f + fexp(-fabsf(x))); }

__device__ const unsigned char T5B[128] = {0,1,2,3,4,5,6,7,8,9,10,11,12,13,14,15,16,16,16,17,17,18,18,18,19,19,19,20,20,20,20,21,21,21,21,22,22,22,22,22,23,23,23,23,23,23,24,24,24,24,24,24,25,25,25,25,25,25,25,26,26,26,26,26,26,26,26,27,27,27,27,27,27,27,27,27,27,28,28,28,28,28,28,28,28,28,28,29,29,29,29,29,29,29,29,29,29,29,29,30,30,30,30,30,30,30,30,30,30,30,30,30,30,31,31,31,31,31,31,31,31,31,31,31,31,31,31,31};

namespace pg8 {
constexpr int BM = 256, BK = 64, HALF = 128, HTB = HALF * BK * 2, STAGE_BYTES = 8 * HTB, NXCD = 8, WGM = 4;
__host__ __device__ __forceinline__ int lds_byte(int r, int c) { const int st = (r >> 4) * 2 + (c >> 5), rr = r & 15, cc = c & 31, ob = rr * 64 + cc * 2; return st * 1024 + (ob ^ (((ob >> 9) & 1) << 5)); }
__host__ __device__ __forceinline__ void stage_rc(int b, int& R, int& C) { const int st = b / 1024, sb = b % 1024, swz = sb ^ (((sb >> 9) & 1) << 5); R = (st >> 1) * 16 + swz / 64; C = (st & 1) * 32 + (swz % 64) / 2; }
__host__ __device__ __forceinline__ int perm32(int rho) { const int n = rho >> 4, i = rho & 15; return 8 * (i >> 2) + 4 * n + (i & 3); }

struct Unit { int pm, pn, rp, lst, lst2; };
struct Gemm { const bf16_t* A; const bf16_t* Bt; int lda, ldb, K, a_pn_koff; size_t b_bstride = 0; size_t a_kstep = 0, a_tstep = 0; };

struct StaticOrder {
    int nM, nN, nwg, G, c, reps;
    __host__ __device__ void init(int M, int N, int G_, int c_, int reps_ = 1) { nM = M / BM; nN = N / BM; nwg = nM * nN; G = G_; c = c_; reps = reps_; }
    __host__ __device__ bool next(int i, Unit& u) const {
        int L = i * G + c; if (L >= nwg * reps) return false;
        u.rp = (reps > 1) ? L / nwg : 0; L -= u.rp * nwg;
        const int wgid = (L % NXCD) * (nwg / NXCD) + L / NXCD;
        const int nig = WGM * nN, gid = wgid / nig, idx = wgid - gid * nig;
        u.pm = gid * WGM + (idx % WGM); u.pn = idx / WGM; return true;
    }
};

DI u32x4 ror8(u32x4 v) { u32x4 r;
#pragma unroll
    for (int k = 0; k < 4; ++k) r[k] = (unsigned)__builtin_amdgcn_update_dpp(0, (int)v[k], 0x128, 0xf, 0xf, false);
    return r; }
DI u32x4 sel4(bool c, u32x4 a, u32x4 b) { u32x4 r;
#pragma unroll
    for (int k = 0; k < 4; ++k) r[k] = c ? a[k] : b[k];
    return r; }
template <int ACT  > struct EpiBf16 {
    static constexpr bool PERM = true;
    bf16_t* O; int ldc; const float* rowss; const float* bias; int nbias;
    __device__ __forceinline__ void operator()(const f32x4 (&acc)[2][2][4][2], const Unit& u, int wr, int wc, int fr, int fq) const {
        { const int l_ = opaque_lane(); fr = l_ & 15; fq = l_ >> 4; }
        const int row0 = u.pm * BM + wr * 64 + fr; const int col0 = u.pn * BM + wc * 64 + 8 * fq;
        const bool lo = fr < 8;
        f32x4 bv[2][2]; float rs[2][4];
#pragma unroll
        for (int ai = 0; ai < 2; ++ai)
#pragma unroll
            for (int m = 0; m < 4; ++m) rs[ai][m] = rowss[row0 + ai * HALF + m * 16];
#pragma unroll
        for (int bj = 0; bj < 2; ++bj)
#pragma unroll
            for (int n = 0; n < 2; ++n) bv[bj][n] = *(const f32x4*)(bias + (size_t)(u.pm >> 5) * nbias + col0 + bj * 32 + 4 * n);
#pragma unroll
        for (int ai = 0; ai < 2; ++ai)
#pragma unroll
            for (int m = 0; m < 4; ++m) rs[ai][m] = rsqrtf(rs[ai][m] * (1.f / DM) + EPS);
        constexpr bool TILED = true;
        const unsigned rstride = TILED ? 64u : (unsigned)ldc;
        const unsigned obase = TILED ? (((unsigned)(u.pm * ldc + u.pn * 4 + wc) * 16384u + (unsigned)(wr * 64 + (fr & 7)) * 64u + (unsigned)(8 * fq + (lo ? 0 : 32))) * 2u)
                                     : (((unsigned)(u.pm * BM + wr * 64 + (fr & 7)) * (unsigned)ldc + (unsigned)(col0 + (lo ? 0 : 32))) * 2u);
#pragma unroll
        for (int ai = 0; ai < 2; ++ai)
#pragma unroll
            for (int m = 0; m < 4; ++m) { const float rstd = rs[ai][m]; u32x4 w[2];
#pragma unroll
                for (int bj = 0; bj < 2; ++bj) { f32x4 v0 = acc[ai][bj][m][0] * rstd + bv[bj][0], v1 = acc[ai][bj][m][1] * rstd + bv[bj][1];
                    if (ACT == 2) {
#pragma unroll
                        for (int e = 0; e < 4; ++e) { const float a = fmaxf(v0[e], 0.f), b = fmaxf(v1[e], 0.f); v0[e] = a * a; v1[e] = b * b; } }
                    w[bj].x = cvtpk(v0[0], v0[1]); w[bj].y = cvtpk(v0[2], v0[3]); w[bj].z = cvtpk(v1[0], v1[1]); w[bj].w = cvtpk(v1[2], v1[3]); }
                const u32x4 rcv = ror8(sel4(lo, w[1], w[0]));
                const unsigned rp = obase + (unsigned)((ai * HALF + m * 16) * 2) * rstride;
                if (u.lst2) { st16_wt(O, rp, sel4(lo, w[0], rcv));
 st16_wt(O, rp + 16u * rstride, sel4(lo, rcv, w[1])); }
                else { __builtin_nontemporal_store(sel4(lo, w[0], rcv), (u32x4*)((char*)O + rp)); __builtin_nontemporal_store(sel4(lo, rcv, w[1]), (u32x4*)((char*)O + (rp + 16u * rstride))); } }
    }
};
template <bool BASE_F32, bool WRITE_XG> struct EpiRes {
    static constexpr bool PERM = true;
    const void* base; bf16_t* xres; bf16_t* xg; const float* mod_ls; const float* colscale; const float* gnw; const float* mod_next; float* rowss_next; const float* zeros;
    __device__ __forceinline__ void operator()(const f32x4 (&acc)[2][2][4][2], const Unit& u, int wr, int wc, int fr, int fq) const {
        static_assert(!BASE_F32 && !WRITE_XG, "bf16 residual only");
        { const int l_ = opaque_lane(); fr = l_ & 15; fq = l_ >> 4; }
        const int b = u.pm >> 5;
        const float* gate = (u.rp ? zeros : mod_ls) + (size_t)b * 3072 + 2048;
        const int col0 = u.pn * BM + wc * 64 + 8 * fq, rowb = u.pm * BM + wr * 64 + fr;
        const bool lo = fr < 8;
        f32x4 gv[2][2];
#pragma unroll
        for (int bj = 0; bj < 2; ++bj)
#pragma unroll
            for (int n = 0; n < 2; ++n) { const int c = col0 + bj * 32 + 4 * n; gv[bj][n] = *(const f32x4*)(gate + c); if (colscale) gv[bj][n] = gv[bj][n] * *(const f32x4*)(colscale + c); }
        const unsigned obase = ((unsigned)(u.pm * BM + wr * 64 + (fr & 7)) * DM + (unsigned)(col0 + (lo ? 0 : 32))) * 2u;
        float ss[2][4];
#pragma unroll
        for (int ai = 0; ai < 2; ++ai) {
            u32x4 la[4], lb[4];
#pragma unroll
            for (int m = 0; m < 4; ++m) { const unsigned rp = obase + (unsigned)((ai * HALF + m * 16) * 2) * DM; la[m] = *(const u32x4*)((const char*)base + rp); lb[m] = *(const u32x4*)((const char*)base + (rp + 16u * DM)); }
#pragma unroll
            for (int m = 0; m < 4; ++m) { const unsigned rp = obase + (unsigned)((ai * HALF + m * 16) * 2) * DM;
                const u32x4 rb = ror8(sel4(lo, lb[m], la[m]));
                const u32x4 xb[2] = {sel4(lo, la[m], rb), sel4(lo, rb, lb[m])};
                u32x4 w[2]; float sq = 0.f;
#pragma unroll
                for (int bj = 0; bj < 2; ++bj) { const u32x4 w0 = xb[bj];
                    const f32x4 x0 = (f32x4){bflo(w0.x), bfhi(w0.x), bflo(w0.y), bfhi(w0.y)}, x1 = (f32x4){bflo(w0.z), bfhi(w0.z), bflo(w0.w), bfhi(w0.w)};
                    const f32x4 v0 = x0 + gv[bj][0] * acc[ai][bj][m][0], v1 = x1 + gv[bj][1] * acc[ai][bj][m][1];
                    sq += (v0[0] * v0[0] + v0[1] * v0[1]) + (v0[2] * v0[2] + v0[3] * v0[3]) + (v1[0] * v1[0] + v1[1] * v1[1]) + (v1[2] * v1[2] + v1[3] * v1[3]);
                    w[bj].x = cvtpk(v0[0], v0[1]); w[bj].y = cvtpk(v0[2], v0[3]); w[bj].z = cvtpk(v1[0], v1[1]); w[bj].w = cvtpk(v1[2], v1[3]); }
                ss[ai][m] = sq;
                const u32x4 rcv = ror8(sel4(lo, w[1], w[0]));
                if (u.lst) { st16_wt(xres, rp, sel4(lo, w[0], rcv)); st16_wt(xres, rp + 16u * DM, sel4(lo, rcv, w[1])); }
                else { *(u32x4*)((char*)xres + rp) = sel4(lo, w[0], rcv); *(u32x4*)((char*)xres + (rp + 16u * DM)) = sel4(lo, rcv, w[1]); }
                __builtin_amdgcn_sched_barrier(0); }
        }
#pragma unroll
        for (int ai = 0; ai < 2; ++ai)
#pragma unroll
            for (int m = 0; m < 4; ++m) { float t = ss[ai][m]; t += __shfl_xor(t, 16); t += __shfl_xor(t, 32); ss[ai][m] = t; }
        if (u.rp == 0 && rowss_next) {
#pragma unroll
            for (int ai = 0; ai < 2; ++ai) { const float t = fq == 0 ? ss[ai][0] : fq == 1 ? ss[ai][1] : fq == 2 ? ss[ai][2] : ss[ai][3];
                atomicAdd(rowss_next + rowb + ai * HALF + fq * 16, t); } }
    }
};

template <class Epi, bool ALIGN_EPI, bool SP2>
__device__ __forceinline__ void gemm_phase(LAS unsigned char* lds, const Gemm g, const StaticOrder& S, const Epi& E, int wave) {
    const int wid = wave, lane = lane_id(), tid = wid * 64 + lane, wr = wid >> 2, wc = wid & 3, fr = lane & 15, fq = lane >> 4;
    int K = g.K; asm volatile("" : "+s"(K));
    const int nt = K / BK;
    unsigned voffA[2], voffB[2];
#pragma unroll
    for (int i = 0; i < 2; ++i) { int R, C; stage_rc(tid * 16 + i * 8192, R, C); const int Rb = Epi::PERM ? (64 * (R >> 5) + perm32(R & 31)) : R;
        voffA[i] = (unsigned)(R * g.lda + C) * 2u; voffB[i] = (unsigned)(Rb * g.ldb + C) * 2u; }
    const size_t kstep = (size_t)(BK * 2);
    const size_t hstepA = (size_t)HALF * g.lda * 2, hstepB = (size_t)(Epi::PERM ? 32 : HALF) * g.ldb * 2;
    const size_t tstepA = g.a_tstep ? g.a_tstep : 2 * hstepA, tstepB = (size_t)BM * g.ldb * 2;
    const size_t kstepA = g.a_kstep ? g.a_kstep : kstep;
    const unsigned ldsw = (unsigned)wid * 1024u;
    const int aoff = lds_byte(wr * 64 + fr, fq * 8), boff = lds_byte(wc * 32 + fr, fq * 8);
#define PG8_SA(b, h) (((b) * 2 + (h)) * HTB)
#define PG8_SB(b, h) ((4 + (b) * 2 + (h)) * HTB)
#define PG8_STAGE(bufoff, gbase, voff) do { _Pragma("unroll") for (int _i = 0; _i < 2; ++_i) \
        __builtin_amdgcn_global_load_lds((const unsigned*)((const char*)(gbase) + (voff)[_i]), (LAS unsigned*)(lds + (bufoff) + ldsw + _i * 8192), 16, 0, 0); } while (0)
#define PG8_LDA(dst, b, h) do { _Pragma("unroll") for (int m = 0; m < 4; ++m) _Pragma("unroll") for (int k = 0; k < 2; ++k) dst[m][k] = *(const LAS bf16x8*)(lds + PG8_SA(b, h) + aoff + m * 2048 + k * 1024); } while (0)
#define PG8_LDB(dst, b, h) do { _Pragma("unroll") for (int n = 0; n < 2; ++n) _Pragma("unroll") for (int k = 0; k < 2; ++k) dst[n][k] = *(const LAS bf16x8*)(lds + PG8_SB(b, h) + boff + n * 2048 + k * 1024); } while (0)
#define PG8_MMA(ai, bj, At, Bt) do { __builtin_amdgcn_s_setprio(1); _Pragma("unroll") for (int m = 0; m < 4; ++m) _Pragma("unroll") for (int n = 0; n < 2; ++n) _Pragma("unroll") for (int k = 0; k < 2; ++k) \
        acc[ai][bj][m][n] = __builtin_amdgcn_mfma_f32_16x16x32_bf16(Bt[n][k], At[m][k], acc[ai][bj][m][n], 0, 0, 0); __builtin_amdgcn_s_setprio(0); } while (0)
#define PG8_WAIT_V(n) asm volatile("s_waitcnt vmcnt(" #n ")" ::: "memory")
#define PG8_WAIT_L(n) asm volatile("s_waitcnt lgkmcnt(" #n ")" ::: "memory")
#define PG8_BAR __builtin_amdgcn_s_barrier()
#define PG8_SCHED __builtin_amdgcn_sched_barrier(0)
    Unit cur, nxt; int ui = 0;
    if (!S.next(0, cur)) return;
    f32x4 acc[2][2][4][2];
#pragma unroll
    for (int a = 0; a < 2; ++a)
#pragma unroll
        for (int b = 0; b < 2; ++b)
#pragma unroll
            for (int m = 0; m < 4; ++m)
#pragma unroll
                for (int n = 0; n < 2; ++n) acc[a][b][m][n] = (f32x4){0.f, 0.f, 0.f, 0.f};
    bf16x8 At[4][2], B0[2][2], B1[2][2];
    const char* cA = (const char*)g.A + (size_t)cur.pm * tstepA + (size_t)cur.pn * g.a_pn_koff * 2; const char* cB = (const char*)g.Bt + (size_t)(cur.pm >> 5) * g.b_bstride * 2 + (size_t)cur.pn * tstepB;
    if constexpr (SP2) {
        PG8_STAGE(PG8_SB(0, 0), cB, voffB); PG8_STAGE(PG8_SB(0, 1), cB + hstepB, voffB); PG8_STAGE(PG8_SA(0, 0), cA, voffA); PG8_STAGE(PG8_SA(0, 1), cA + hstepA, voffA);
        if (wr == 1) PG8_BAR;
        PG8_WAIT_V(2); PG8_BAR;
        PG8_STAGE(PG8_SB(1, 0), cB + kstep, voffB); PG8_STAGE(PG8_SA(1, 0), cA + kstepA, voffA); PG8_STAGE(PG8_SB(1, 1), cB + hstepB + kstep, voffB);
        PG8_WAIT_V(6); PG8_BAR;
    } else {
        PG8_STAGE(PG8_SB(0, 0), cB, voffB); PG8_STAGE(PG8_SA(0, 0), cA, voffA); PG8_STAGE(PG8_SB(0, 1), cB + hstepB, voffB); PG8_STAGE(PG8_SA(0, 1), cA + hstepA, voffA);
        if (wr == 1) PG8_BAR;
        PG8_WAIT_V(4); PG8_BAR;
        PG8_STAGE(PG8_SB(1, 0), cB + kstep, voffB); PG8_STAGE(PG8_SA(1, 0), cA + kstepA, voffA); PG8_STAGE(PG8_SB(1, 1), cB + hstepB + kstep, voffB);
        PG8_WAIT_V(6); PG8_BAR;
    }
    for (;;) {
        const bool has_next = S.next(ui + 1, nxt);
        const char* nA = has_next ? (const char*)g.A + (size_t)nxt.pm * tstepA + (size_t)nxt.pn * g.a_pn_koff * 2 : cA; const char* nB = has_next ? (const char*)g.Bt + (size_t)(nxt.pm >> 5) * g.b_bstride * 2 + (size_t)nxt.pn * tstepB : cB;
        for (int t = 0; t < nt; t += 2) {
            const bool last = (t == nt - 2);
            const char* a1 = cA + (size_t)(t + 1) * kstepA;
            const char* a2 = last ? nA : cA + (size_t)(t + 2) * kstepA; const char* b2 = last ? nB : cB + (size_t)(t + 2) * kstep;
            const char* a3 = a2 + kstepA; const char* b3 = b2 + kstep;
            if constexpr (SP2) {
            PG8_LDB(B0, 0, 0); PG8_LDB(B1, 0, 1); PG8_SCHED; PG8_LDA(At, 0, 0); PG8_STAGE(PG8_SA(1, 1), a1 + hstepA, voffA);
            PG8_WAIT_V(8); PG8_WAIT_L(0); PG8_BAR; PG8_MMA(0, 0, At, B0); PG8_MMA(0, 1, At, B1); PG8_BAR; PG8_SCHED;
            PG8_LDA(At, 0, 1); PG8_STAGE(PG8_SB(0, 0), b2, voffB); PG8_STAGE(PG8_SB(0, 1), b2 + hstepB, voffB); PG8_STAGE(PG8_SA(0, 0), a2, voffA);
            PG8_WAIT_V(8); PG8_WAIT_L(0); PG8_BAR; PG8_MMA(1, 0, At, B0); PG8_MMA(1, 1, At, B1); PG8_BAR; PG8_SCHED;
            PG8_LDB(B0, 1, 0); PG8_LDB(B1, 1, 1); PG8_SCHED; PG8_LDA(At, 1, 0); PG8_STAGE(PG8_SA(0, 1), a2 + hstepA, voffA);
            PG8_WAIT_V(8); PG8_WAIT_L(0); PG8_BAR; PG8_MMA(0, 0, At, B0); PG8_MMA(0, 1, At, B1); PG8_BAR; PG8_SCHED;
            PG8_LDA(At, 1, 1); PG8_STAGE(PG8_SB(1, 0), b3, voffB); PG8_STAGE(PG8_SB(1, 1), b3 + hstepB, voffB); PG8_STAGE(PG8_SA(1, 0), a3, voffA);
            PG8_WAIT_V(8); PG8_WAIT_L(0); PG8_BAR; PG8_MMA(1, 0, At, B0); PG8_MMA(1, 1, At, B1); PG8_BAR; PG8_SCHED;
            } else {
            PG8_LDB(B0, 0, 0); PG8_SCHED; PG8_LDA(At, 0, 0); PG8_STAGE(PG8_SA(1, 1), a1 + hstepA, voffA);
            PG8_WAIT_L(8); PG8_BAR; PG8_WAIT_L(0); PG8_MMA(0, 0, At, B0); PG8_BAR; PG8_SCHED;
            PG8_LDB(B1, 0, 1); PG8_STAGE(PG8_SB(0, 0), b2, voffB);
            PG8_BAR; PG8_WAIT_L(0); PG8_MMA(0, 1, At, B1); PG8_BAR;
            PG8_LDA(At, 0, 1); PG8_STAGE(PG8_SA(0, 0), a2, voffA);
            PG8_BAR; PG8_WAIT_L(0); PG8_MMA(1, 0, At, B0); PG8_BAR; PG8_SCHED;
            PG8_STAGE(PG8_SB(0, 1), b2 + hstepB, voffB);
            PG8_WAIT_V(6); PG8_BAR; PG8_MMA(1, 1, At, B1); PG8_BAR;
            PG8_LDB(B0, 1, 0); PG8_SCHED; PG8_LDA(At, 1, 0); PG8_STAGE(PG8_SA(0, 1), a2 + hstepA, voffA);
            PG8_WAIT_L(8); PG8_BAR; PG8_WAIT_L(0); PG8_MMA(0, 0, At, B0); PG8_BAR; PG8_SCHED;
            PG8_LDB(B1, 1, 1); PG8_STAGE(PG8_SB(1, 0), b3, voffB);
            PG8_BAR; PG8_WAIT_L(0); PG8_MMA(0, 1, At, B1); PG8_BAR;
            PG8_LDA(At, 1, 1); PG8_STAGE(PG8_SA(1, 0), a3, voffA);
            PG8_BAR; PG8_WAIT_L(0); PG8_MMA(1, 0, At, B0); PG8_BAR; PG8_SCHED;
            PG8_STAGE(PG8_SB(1, 1), b3 + hstepB, voffB);
            PG8_WAIT_V(6); PG8_BAR; PG8_MMA(1, 1, At, B1); PG8_BAR;
            }
        }
        if constexpr (ALIGN_EPI) { if (wr == 0) PG8_BAR; }
        cur.lst = has_next ? 0 : 1; { Unit t2_; cur.lst2 = (has_next && S.next(ui + 2, t2_)) ? 0 : 1; }
        E(acc, cur, wr, wc, fr, fq);
        if (!has_next) break;
#pragma unroll
        for (int a = 0; a < 2; ++a)
#pragma unroll
            for (int b = 0; b < 2; ++b)
#pragma unroll
                for (int m = 0; m < 4; ++m)
#pragma unroll
                    for (int n = 0; n < 2; ++n) acc[a][b][m][n] = (f32x4){0.f, 0.f, 0.f, 0.f};
        cur = nxt; cA = nA; cB = nB; ++ui;
        if constexpr (ALIGN_EPI) { if (wr == 1) PG8_BAR; }
    }
    PG8_WAIT_V(0);
    if constexpr (!ALIGN_EPI) { if (wr == 0) PG8_BAR; }
    PG8_BAR;
#undef PG8_SA
#undef PG8_SB
#undef PG8_STAGE
#undef PG8_LDA
#undef PG8_LDB
#undef PG8_MMA
#undef PG8_WAIT_V
#undef PG8_WAIT_L
#undef PG8_BAR
#undef PG8_SCHED
}
}

#define XB_TMO      128
#define XB_XCNT(j)  (256  + 64 * (j))
#define XB_XSUB(j)  (1280 + 64 * (j))
#define XB_XGEN(j)  (2304 + 64 * (j))
#define XB_TOP      3328
#define XB_TOPGEN   3392
#define XCD_BAR_WORDS 3456
#define XB_SPIN_CAP (1u << 18)
DI unsigned xb_ld(unsigned* p)              { return __hip_atomic_load(p, __ATOMIC_RELAXED, __HIP_MEMORY_SCOPE_AGENT); }
DI unsigned xb_add(unsigned* p, unsigned v) { return __hip_atomic_fetch_add(p, v, __ATOMIC_RELAXED, __HIP_MEMORY_SCOPE_AGENT); }
DI unsigned xb_xcc_id() { return (unsigned)__builtin_amdgcn_s_getreg((3 << 11) | 20) & 0xFu; }
#define XB_SPIN(cond, bar) do { unsigned _sp = 0; while (cond) { __builtin_amdgcn_s_sleep(1); \
    if ((++_sp & 255u) == 0u) { if (xb_ld(&(bar)[XB_TMO])) break; if (_sp > XB_SPIN_CAP) { atomicAdd(&(bar)[XB_TMO], 1u); break; } } } } while (0)
struct XcdBarrier { unsigned* bar; unsigned x; volatile LAS unsigned* st; int wave; };
DI XcdBarrier xcd_barrier_post(unsigned* bar, volatile LAS unsigned* st, int wave) {
    XcdBarrier b; b.bar = bar; b.x = xb_xcc_id(); b.st = st; b.wave = wave;
    if (wave == 0 && lane_id() == 0) st[2] = xb_add(&bar[XB_XCNT(b.x)], 1u);
    return b;
}
DI void xcd_barrier_complete(unsigned* bar, unsigned x, unsigned& nloc, unsigned& nx, unsigned& uni) {
    const unsigned G = gridDim.x * gridDim.y * gridDim.z;
    unsigned sum, cnt, mine, sp = 0u, all32 = 0u;
    for (;;) {
        sum = 0u; cnt = 0u; mine = 0u; all32 = 1u;
#pragma unroll
        for (unsigned j = 0; j < 16; ++j) { const unsigned c = xb_ld(&bar[XB_XCNT(j)]); sum += c; cnt += (c > 0u) ? 1u : 0u; mine = (j == x) ? c : mine; all32 &= (c == (j < 8u ? 32u : 0u)) ? 1u : 0u; }
        if (sum == G) break;
        __builtin_amdgcn_s_sleep(1);
        if ((++sp & 255u) == 0u) { if (xb_ld(&bar[XB_TMO])) break; if (sp > XB_SPIN_CAP) { atomicAdd(&bar[XB_TMO], 1u); break; } }
    }
    nloc = mine > 0u ? mine : 1u; nx = cnt > 0u ? cnt : 1u; uni = (sum == G && G == 256u) ? all32 : 0u;
}
DI void xcd_barrier(const XcdBarrier& b, int local = 0) {
    asm volatile("s_waitcnt vmcnt(0)" ::: "memory");
    __syncthreads();
    if (b.wave == 0 && lane_id() == 0) {
        unsigned* bar = b.bar;
        __builtin_amdgcn_s_waitcnt(0);
        unsigned nloc = b.st[0], nx = b.st[1];
        if (nloc == 0u) { unsigned uni; xcd_barrier_complete(bar, b.x, nloc, nx, uni); b.st[0] = nloc; b.st[1] = nx; b.st[3] = uni; }
        const unsigned old = xb_add(&bar[XB_XSUB(b.x)], 1u);
        const unsigned gen = old / nloc;
        if (old + 1u == (gen + 1u) * nloc) {
            if (!local) {
            __builtin_amdgcn_fence(__ATOMIC_RELEASE, "agent");
            asm volatile("s_waitcnt vmcnt(0)" ::: "memory");
            const unsigned og = xb_add(&bar[XB_TOP], 1u);
            const unsigned tg = og / nx;
            if (og + 1u == (tg + 1u) * nx) xb_add(&bar[XB_TOPGEN], 1u);
            else XB_SPIN(xb_ld(&bar[XB_TOPGEN]) == tg, bar);
            }
            __builtin_amdgcn_fence(__ATOMIC_ACQUIRE, "agent");
            xb_add(&bar[XB_XGEN(b.x)], 1u);
            asm volatile("s_waitcnt vmcnt(0)" ::: "memory");
        } else {
            XB_SPIN(xb_ld(&bar[XB_XGEN(b.x)]) == gen, bar);
            __builtin_amdgcn_fence(__ATOMIC_ACQUIRE, "agent");
            asm volatile("s_waitcnt vmcnt(0)" ::: "memory");
        }
    }
    __syncthreads();
}

DI void p0_mod_unit(int unit, const float* c, const float* ada_w, const float* ada_b, float* MOD, LAS unsigned char* lds, int tid, int wave, int lane) {
    LAS float* sc = (LAS float*)lds;
    LAS float* red = (LAS float*)(lds + 16384);
    const int ls = unit >> 6, j0 = (unit & 63) * 48, ln = lane < 48 ? lane : 47;
    for (int k = tid; k < 1024; k += NTHR) {
#pragma unroll
        for (int b = 0; b < 4; ++b) sc[k * 4 + b] = silu_f(c[b * 1024 + k]);
    }
    __syncthreads();
    const float* w = ada_w + (size_t)ls * 1024 * 3072 + (size_t)(wave * 128) * 3072 + j0 + ln;
    float a0 = 0.f, a1 = 0.f, a2 = 0.f, a3 = 0.f;
#pragma unroll 1
    for (int k0 = 0; k0 < 128; k0 += 32) { float wv[32];
#pragma unroll
        for (int k = 0; k < 32; ++k) wv[k] = __builtin_nontemporal_load(w + (size_t)(k0 + k) * 3072);
#pragma unroll
        for (int k = 0; k < 32; ++k) { const f32x4 s4 = *(const LAS f32x4*)(sc + (wave * 128 + k0 + k) * 4); a0 += wv[k] * s4[0]; a1 += wv[k] * s4[1]; a2 += wv[k] * s4[2]; a3 += wv[k] * s4[3]; } }
    red[(wave * 4 + 0) * 64 + lane] = a0; red[(wave * 4 + 1) * 64 + lane] = a1; red[(wave * 4 + 2) * 64 + lane] = a2; red[(wave * 4 + 3) * 64 + lane] = a3;
    __syncthreads();
    if (wave < 4 && lane < 48) { float sm = ada_b[ls * 3072 + j0 + lane];
#pragma unroll
        for (int w8 = 0; w8 < 8; ++w8) sm += red[(w8 * 4 + wave) * 64 + lane];
        MOD[((size_t)ls * 4 + wave) * 3072 + j0 + lane] = sm; }
    __syncthreads();
}
DI void p0_transpose_item(const float* W, int ldw, int src_col0, bf16_t* WT, int K, int dst_row0, int k0, LAS float* scr, int lane) {
    float wv[32];
#pragma unroll
    for (int i = 0; i < 32; ++i) { const int kk = 2 * i + (lane >> 5); wv[i] = __builtin_nontemporal_load(W + (size_t)(k0 + kk) * ldw + src_col0 + (lane & 31)); }
#pragma unroll
    for (int i = 0; i < 32; ++i) { const int kk = 2 * i + (lane >> 5); scr[kk * 33 + (lane & 31)] = wv[i]; }
    asm volatile("s_waitcnt lgkmcnt(0)" ::: "memory");
    const int c = lane & 7;
#pragma unroll
    for (int j = 0; j < 4; ++j) { const int n = (lane >> 3) + 8 * j; const LAS float* s = scr + (8 * c) * 33 + n;
        u32x4 o; o.x = cvtpk(s[0 * 33], s[1 * 33]); o.y = cvtpk(s[2 * 33], s[3 * 33]); o.z = cvtpk(s[4 * 33], s[5 * 33]); o.w = cvtpk(s[6 * 33], s[7 * 33]);
        *(u32x4*)(WT + (size_t)(dst_row0 + n) * K + k0 + 8 * c) = o; }
    asm volatile("s_waitcnt lgkmcnt(0)" ::: "memory");
}
DI void p0_gatefold_item(const float* Win, const float* wgate, bf16_t* WT, int n0, int k0, LAS float* scr, int lane) {
    const int nn = lane & 31;
    float wg[16];
#pragma unroll
    for (int r = 0; r < 16; ++r) wg[r] = wgate[r * 256 + n0 + nn];
    for (int i = 0; i < 32; ++i) { const int kk = 2 * i + (lane >> 5); const float* src = Win + (size_t)(k0 + kk) * INCOLS + 1536; float s = 0.f;
#pragma unroll
        for (int r = 0; r < 16; ++r) s += src[r] * wg[r];
        scr[kk * 33 + nn] = s; }
    asm volatile("s_waitcnt lgkmcnt(0)" ::: "memory");
    const int c = lane & 7;
#pragma unroll
    for (int j = 0; j < 4; ++j) { const int n = (lane >> 3) + 8 * j; const LAS float* s = scr + (8 * c) * 33 + n;
        u32x4 o; o.x = cvtpk(s[0 * 33], s[1 * 33]); o.y = cvtpk(s[2 * 33], s[3 * 33]); o.z = cvtpk(s[4 * 33], s[5 * 33]); o.w = cvtpk(s[6 * 33], s[7 * 33]);
        *(u32x4*)(WT + (size_t)(PC_GL + n0 + n) * 1024 + k0 + 8 * c) = o; }
    asm volatile("s_waitcnt lgkmcnt(0)" ::: "memory");
}
DI void convert_rows(const float* X, bf16_t* XB, float* RS, int gw, int NGW, int lane) {
    for (int m0 = gw; m0 < MTOK; m0 += 2 * NGW) {
        const int m1 = m0 + NGW; const bool has1 = m1 < MTOK;
        const f32x4* xr0 = (const f32x4*)(X + (size_t)m0 * DM) + lane; const f32x4* xr1 = (const f32x4*)(X + (size_t)(has1 ? m1 : m0) * DM) + lane;
        f32x4 v0[4], v1[4];
#pragma unroll
        for (int j = 0; j < 4; ++j) { v0[j] = __builtin_nontemporal_load(xr0 + 64 * j); v1[j] = __builtin_nontemporal_load(xr1 + 64 * j); }
#pragma unroll
        for (int rr = 0; rr < 2; ++rr) { if (rr == 1 && !has1) break;
            const int m = rr ? m1 : m0;
            float s = 0.f;
#pragma unroll
            for (int j = 0; j < 4; ++j) { const f32x4 v = rr ? v1[j] : v0[j]; s += (v.x * v.x + v.y * v.y) + (v.z * v.z + v.w * v.w); }
            s = wave_sum(s); if (lane == 0) RS[m] = s;
#pragma unroll
            for (int j = 0; j < 4; ++j) { const f32x4 v = rr ? v1[j] : v0[j]; u32x2 w; w.x = cvtpk(v.x, v.y); w.y = cvtpk(v.z, v.w); st8_wt(XB, (unsigned)m * (DM * 2) + (unsigned)(lane + 64 * j) * 8u, w); } }
    }
}
DI void p1_fold_tile(bf16_t* WF, size_t bstride, int ldk, int dst_row0, int k0, int gk0, const float* nw, const float* mod_ls, float* bias, int nbias, const float* extra, LAS float* scr, int lane) {
    LAS float* G = scr + 2112; LAS float* SH = scr + 2368;
    { const int b = lane >> 4, kq = 4 * (lane & 15);
#pragma unroll
      for (int q = 0; q < 4; ++q) { const int k = gk0 + kq + q; G[b * 64 + kq + q] = nw[k] * (1.0f + mod_ls[(size_t)b * 3072 + 1024 + k]); SH[b * 64 + kq + q] = mod_ls[(size_t)b * 3072 + k]; } }
    asm volatile("s_waitcnt lgkmcnt(0)" ::: "memory");
    const int c = lane & 7;
#pragma unroll
    for (int j = 0; j < 4; ++j) { const int n = (lane >> 3) + 8 * j; const LAS float* t = scr + (8 * c) * 33 + n; float w[8];
#pragma unroll
        for (int e = 0; e < 8; ++e) w[e] = t[e * 33];
#pragma unroll
        for (int b = 0; b < 4; ++b) { const LAS float* gb = G + b * 64 + 8 * c;
            u32x4 o; o.x = cvtpk(w[0] * gb[0], w[1] * gb[1]); o.y = cvtpk(w[2] * gb[2], w[3] * gb[3]); o.z = cvtpk(w[4] * gb[4], w[5] * gb[5]); o.w = cvtpk(w[6] * gb[6], w[7] * gb[7]);
            *(u32x4*)(WF + (size_t)b * bstride + (size_t)(dst_row0 + n) * ldk + k0 + 8 * c) = o; } }
    if (bias) { const int n = lane & 31, b0 = 2 * (lane >> 5); float a0 = 0.f, a1 = 0.f;
#pragma unroll 8
      for (int kk = 0; kk < 64; ++kk) { const float w = scr[kk * 33 + n]; a0 += w * SH[b0 * 64 + kk]; a1 += w * SH[(b0 + 1) * 64 + kk]; }
      if (extra && k0 == 0) { const float ex = extra[n]; a0 += ex; a1 += ex; }
      atomicAdd(bias + (size_t)b0 * nbias + dst_row0 + n, a0); atomicAdd(bias + (size_t)(b0 + 1) * nbias + dst_row0 + n, a1); }
    asm volatile("s_waitcnt lgkmcnt(0)" ::: "memory");
}
DI void p1_fold_item(const float* W, int ldw, int src_col0, bf16_t* WF, size_t bstride, int ldk, int dst_row0, int k0, int gk0, const float* nw, const float* mod_ls, float* bias, int nbias, LAS float* scr, int lane) {
    float wv[32];
#pragma unroll
    for (int i = 0; i < 32; ++i) { const int kk = 2 * i + (lane >> 5); wv[i] = __builtin_nontemporal_load(W + (size_t)(k0 + kk) * ldw + src_col0 + (lane & 31)); }
#pragma unroll
    for (int i = 0; i < 32; ++i) { const int kk = 2 * i + (lane >> 5); scr[kk * 33 + (lane & 31)] = wv[i]; }
    p1_fold_tile(WF, bstride, ldk, dst_row0, k0, gk0, nw, mod_ls, bias, nbias, nullptr, scr, lane);
}
DI void p1_gatefold_item(const float* Win, const float* wgate, const float* bgate, bf16_t* WF, size_t bstride, int n0, int k0, const float* nw, const float* mod_ls, float* bias, int nbias, LAS float* scr, int lane) {
    const int nn = lane & 31;
    float wg[16];
#pragma unroll
    for (int r = 0; r < 16; ++r) wg[r] = wgate[r * 256 + n0 + nn];
    for (int i = 0; i < 32; ++i) { const int kk = 2 * i + (lane >> 5); const float* src = Win + (size_t)(k0 + kk) * INCOLS + 1536; float sm = 0.f;
#pragma unroll
        for (int r = 0; r < 16; ++r) sm += src[r] * wg[r];
        scr[kk * 33 + nn] = sm; }
    p1_fold_tile(WF, bstride, 1024, PC_GL + n0, k0, k0, nw, mod_ls, bias, nbias, bgate + n0, scr, lane);
}
DI void final_norm_rows(const bf16_t* X1B, const float* RS, float* OUT, const float* fw, int m_first, int m_end, int m_step, int lane) {
    f32x4 w[4];
#pragma unroll
    for (int j = 0; j < 4; ++j) w[j] = *((const f32x4*)fw + lane + 64 * j);
    for (int m = m_first; m < m_end; m += m_step) {
        const u32x2* xr = (const u32x2*)(X1B + (size_t)m * DM) + lane;
        u32x2 a[4];
#pragma unroll
        for (int j = 0; j < 4; ++j) a[j] = __builtin_nontemporal_load(xr + 64 * j);
        float ssq = 0.f;
#pragma unroll
        for (int j = 0; j < 4; ++j) { const float p0 = bflo(a[j].x), p1 = bfhi(a[j].x), p2 = bflo(a[j].y), p3 = bfhi(a[j].y); ssq += (p0 * p0 + p1 * p1) + (p2 * p2 + p3 * p3); }
        const float rstd = rsqrtf(wave_sum(ssq) * (1.f / DM) + EPS);
        f32x4* o = (f32x4*)(OUT + (size_t)m * DM) + lane;
#pragma unroll
        for (int j = 0; j < 4; ++j) __builtin_nontemporal_store((f32x4){bflo(a[j].x), bfhi(a[j].x), bflo(a[j].y), bfhi(a[j].y)} * rstd * w[j], o + 64 * j);
    }
}
template <int W> DI void pool_run(const bf16_t* X, bf16_t* POOL, const LAS float* rsv, int grow0, int t0, int c0) {
    const int boff = grow0 * (DM * 2) + c0 * 2;
    u32x4 buf[24];
#pragma unroll
    for (int u = 0; u < 24; ++u) { const int r = grow0 + u; buf[u] = (u32x4){0u, 0u, 0u, 0u}; if (u < 8) buf[u] = *(const u32x4*)((const char*)X + (unsigned)((r < 0 ? 0 : r) * (DM * 2) + c0 * 2)); }
    f32x4 S0 = (f32x4){0.f, 0.f, 0.f, 0.f}, S1 = S0;
#pragma unroll 1
    for (int base = 0; base < 48; base += 24) {
        unsigned off = (unsigned)(boff + base * (DM * 2)); asm volatile("" : "+v"(off));
#pragma unroll
        for (int u = 0; u < 24; ++u) { const int rl = base + u;
            {
                const u32x4 nw = buf[u], od = buf[(u - W + 24) % 24];
                { const int rr = (u + 8 < 46 - base) ? u + 8 : 46 - base; const int o = (int)off + rr * (DM * 2); const u32x4* lp = (const u32x4*)((const char*)X + (unsigned)(o < 0 ? 0 : o)); const int rq = rl + 8; buf[(u + 8) % 24] = (rq >= 15 && rq < 32) ? __builtin_nontemporal_load(lp) : *lp; }
                const float rn = rsv[rl], ro = -rsv[rl - W];
                const f32x4 un0 = (f32x4){bflo(nw.x), bfhi(nw.x), bflo(nw.y), bfhi(nw.y)} * rn, un1 = (f32x4){bflo(nw.z), bfhi(nw.z), bflo(nw.w), bfhi(nw.w)} * rn;
                S0 += un0; S1 += un1;
                S0 += (f32x4){bflo(od.x), bfhi(od.x), bflo(od.y), bfhi(od.y)} * ro; S1 += (f32x4){bflo(od.z), bfhi(od.z), bflo(od.w), bfhi(od.w)} * ro;
                if (rl >= 15 && rl < 47) { const int t = t0 + rl; const float ic = __builtin_amdgcn_rcpf((float)((t + 1 < W) ? t + 1 : W)); const f32x4 p0 = S0 * ic - un0, p1 = S1 * ic - un1;
                    u32x4 o; o.x = cvtpk(p0[0], p0[1]); o.y = cvtpk(p0[2], p0[3]); o.z = cvtpk(p1[0], p1[1]); o.w = cvtpk(p1[2], p1[3]);
                    *(u32x4*)((char*)POOL + (unsigned)(off + (unsigned)(u * (DM * 2)))) = o; }
                __builtin_amdgcn_sched_barrier(0);
            }
        }
    }
}
DI void pool_prelude(const pg8::StaticOrder& S, const bf16_t* X, const float* RS, bf16_t* POOL, LAS unsigned char* lds, int tid, int wave) {
    const int half = wave >> 2, ht = tid & 255, cg = ht & 31, rg = ht >> 5;
    LAS float* rsv = (LAS float*)lds + half * 320;
#pragma unroll 1
    for (int i0 = 0; ; i0 += 2) {
        pg8::Unit u0, u; if (!S.next(i0, u0)) break;
        const bool have = S.next(i0 + half, u);
        __syncthreads();
        if (have) { const int tb = (u.pm * 256) & (SEQ - 1);
            for (int j = ht; j < 288; j += 256) { const int tj = tb - 31 + j; rsv[j] = (j >= 16 && j < 287 && tj >= 0) ? rsqrtf(RS[u.pm * 256 - 31 + j] * (1.f / DM) + EPS) : 0.f; } }
        __syncthreads();
        if (have) { const int grow0 = u.pm * 256 - 15 + 32 * rg, t0 = ((u.pm * 256) & (SEQ - 1)) - 15 + 32 * rg, c0 = u.pn * 256 + 8 * cg; const LAS float* rv = rsv + 16 + 32 * rg;
            if (u.pn == 0) pool_run<2>(X, POOL, rv, grow0, t0, c0); else if (u.pn == 1) pool_run<4>(X, POOL, rv, grow0, t0, c0); else if (u.pn == 2) pool_run<8>(X, POOL, rv, grow0, t0, c0); else pool_run<16>(X, POOL, rv, grow0, t0, c0); }
    }
    asm volatile("s_waitcnt vmcnt(0)" ::: "memory");
    __syncthreads();
}

#define MFMA32(a, b, c) __builtin_amdgcn_mfma_f32_32x32x16_bf16((a), (b), (c), 0, 0, 0)
DI int crow(int reg, int hi) { return (reg & 3) + 8 * (reg >> 2) + 4 * hi; }
DI unsigned short f2bf1(float f) { return (unsigned short)(cvtpk(f, 0.f) & 0xffffu); }
#define LDS_FENCE() asm volatile("s_waitcnt lgkmcnt(0)" ::: "memory")
typedef short v4i16_t __attribute__((ext_vector_type(4)));
DI u32x2 lds_tr16(const LAS unsigned char* p) { return __builtin_bit_cast(u32x2, __builtin_amdgcn_ds_read_tr16_b64_v4i16((LAS v4i16_t*)p)); }

DI void gla_g1_item(int it, const bf16_t* PROJ, float* DS, float* DEC, LAS unsigned char* wl, int lane) {
    const int h = it & 3, n = (it >> 2) & 127, b = it >> 9, r = lane & 31, hi = lane >> 5;
    const size_t grow = (size_t)b * SEQ + (size_t)n * 64;
    LAS unsigned char* ke = wl; LAS unsigned char* st = wl + 9216;
    const int lr = lane >> 3, lc = lane & 7;
    u32x4 tl[8], tk[8], tv[8];
#pragma unroll
    for (int q = 0; q < 8; ++q) { tl[q] = __builtin_nontemporal_load((const u32x4*)(PROJ + proj_off(grow + 8 * q + lr, PC_GL + h * 64 + lc * 8))); tk[q] = __builtin_nontemporal_load((const u32x4*)(PROJ + proj_off(grow + 8 * q + lr, PC_GK + h * 64 + lc * 8))); }
#pragma unroll
    for (int q = 0; q < 8; ++q) *(LAS u32x4*)(st + (8 * q + lr) * 144 + lc * 16) = tl[q];
#pragma unroll
    for (int q = 0; q < 8; ++q) tv[q] = __builtin_nontemporal_load((const u32x4*)(PROJ + proj_off(grow + 8 * q + lr, PC_GV + h * 128 + lc * 8)));
    LDS_FENCE();
    float bc[64]; float run = 0.f;
#pragma unroll
    for (int i = 0; i < 64; ++i) { run += logsigmoid_f(bf2f(*(const LAS unsigned short*)(st + i * 144 + lane * 2))) * (1.f / 16.f); bc[i] = run; }
    DEC[(size_t)it * 64 + lane] = fexp(run);
    LDS_FENCE();
#pragma unroll
    for (int q = 0; q < 8; ++q) *(LAS u32x4*)(st + (8 * q + lr) * 144 + lc * 16) = tk[q];
    LDS_FENCE();
#pragma unroll
    for (int i8 = 0; i8 < 8; ++i8) { u32x4 w;
#pragma unroll
        for (int jj = 0; jj < 4; ++jj) { const int i = 8 * i8 + 2 * jj;
            const float k0 = bf2f(*(const LAS unsigned short*)(st + i * 144 + lane * 2)) * fexp(run - bc[i]), k1 = bf2f(*(const LAS unsigned short*)(st + (i + 1) * 144 + lane * 2)) * fexp(run - bc[i + 1]); w[jj] = cvtpk(k0, k1); }
        *(LAS u32x4*)(ke + lane * 144 + i8 * 16) = w; }
    bf16_t* dsb = (bf16_t*)DS + (size_t)it * 8192;
#pragma unroll 1
    for (int eh = 0; eh < 2; ++eh) {
        LDS_FENCE();
#pragma unroll
        for (int q = 0; q < 8; ++q) *(LAS u32x4*)(st + (8 * q + lr) * 144 + lc * 16) = tv[q];
        if (eh == 0) {
#pragma unroll
            for (int q = 0; q < 8; ++q) tv[q] = __builtin_nontemporal_load((const u32x4*)(PROJ + proj_off(grow + 8 * q + lr, PC_GV + h * 128 + 64 + lc * 8))); }
        LDS_FENCE();
        f32x16 acc[2][2];
#pragma unroll
        for (int et = 0; et < 2; ++et)
#pragma unroll
            for (int dt = 0; dt < 2; ++dt)
#pragma unroll
                for (int q = 0; q < 16; ++q) acc[et][dt][q] = 0.f;
#pragma unroll
        for (int s = 0; s < 4; ++s) { bf16x8 a[2], bb[2];
#pragma unroll
            for (int t = 0; t < 2; ++t) {
                const LAS unsigned char* vr = st + (16 * s + 8 * hi + ((lane & 15) >> 2)) * 144 + (32 * t + 16 * ((lane >> 4) & 1) + 4 * (lane & 3)) * 2;
                const u32x2 lo = lds_tr16(vr), h2 = lds_tr16(vr + 4 * 144); a[t] = __builtin_bit_cast(bf16x8, (u32x4){lo.x, lo.y, h2.x, h2.y});
                bb[t] = *(const LAS bf16x8*)(ke + (32 * t + r) * 144 + (16 * s + 8 * hi) * 2); }
#pragma unroll
            for (int et = 0; et < 2; ++et)
#pragma unroll
                for (int dt = 0; dt < 2; ++dt) acc[et][dt] = MFMA32(bb[dt], a[et], acc[et][dt]); }
        LDS_FENCE();
#pragma unroll
        for (int et = 0; et < 2; ++et)
#pragma unroll
            for (int dt = 0; dt < 2; ++dt)
#pragma unroll
                for (int g4 = 0; g4 < 4; ++g4) { u32x2 w; w.x = cvtpk(acc[et][dt][4 * g4], acc[et][dt][4 * g4 + 1]); w.y = cvtpk(acc[et][dt][4 * g4 + 2], acc[et][dt][4 * g4 + 3]);
                    *(LAS u32x2*)(st + (32 * et + r) * 144 + (32 * dt + 8 * g4 + 4 * hi) * 2) = w; }
        LDS_FENCE();
#pragma unroll
        for (int q = 0; q < 8; ++q) { const u32x4 w = *(const LAS u32x4*)(st + (8 * q + lr) * 144 + lc * 16); *(u32x4*)(dsb + eh * 4096 + (8 * q + lr) * 64 + lc * 8) = w; }
    }
    LDS_FENCE();
}
DI void gla_scan(float* DSf, float* OUTf, const float* DEC, int bx, int G, int tid) {
    bf16_t* DS = (bf16_t*)DSf; bf16_t* OUT = (bf16_t*)OUTf;
    for (int idx = bx * NTHR + tid; idx < NB * 4 * 128 * 64; idx += G * NTHR) {
        const int d = idx & 63, h = (idx >> 13) & 3, b = idx >> 15;
        const size_t o0 = ((size_t)(b * 128) * 4 + h) * 8192 + (idx & 8191); const bf16_t* p = DS + o0; bf16_t* po = OUT + o0; const float* dp = DEC + ((size_t)(b * 128) * 4 + h) * 64 + d;
        float s = 0.f;
#pragma unroll 1
        for (int n0 = 0; n0 < 128; n0 += 16) { float ds[16], dc[16];
#pragma unroll
            for (int u = 0; u < 16; ++u) { ds[u] = bf2f(__builtin_nontemporal_load(p + (size_t)(n0 + u) * 32768)); dc[u] = dp[(size_t)(n0 + u) * 256]; }
#pragma unroll
            for (int u = 0; u < 16; ++u) { po[(size_t)(n0 + u) * 32768] = f2bf1(s); s = dc[u] * s + ds[u]; } }
    }
}
constexpr int G3_QT = 0, G3_KT = 9216, G3_VT = 18432, G3_SS = 36864, G3_ST = 46080, G3_SEG = 64512, G3_PART = 65536, G3_BYTES = 77824;
#define LBAR() asm volatile("s_waitcnt lgkmcnt(0)\n\ts_barrier" ::: "memory")
DI void gla_g3_phase(const bf16_t* PROJ, const float* SIN, const float* gnw, bf16_t* MIX, LAS unsigned char* lds, int ibase, int r_, int nl, int icount, int wave, int lane) {
    const int grp = wave >> 2, w4 = wave & 3, r = lane & 31, hi = lane >> 5;
    LAS unsigned char* gl = lds + grp * G3_BYTES;
    LAS float* SEG = (LAS float*)(gl + G3_SEG); LAS float* PART = (LAS float*)(gl + G3_PART);
    const int i0 = 16 * w4;
    f32x4 gw4[4];
#pragma unroll
    for (int g = 0; g < 4; ++g) gw4[g] = *(const f32x4*)(gnw + 32 * w4 + 8 * g + 4 * hi);
    u32x4 tlg[2], tq[2], tk[2], tvv[4], sv[4], ggq[4];
#define G3_LOAD_A(ITEM) do { const int h_ = (ITEM) & 3, n_ = ((ITEM) >> 2) & 127, b_ = (ITEM) >> 9; \
        const size_t grow_ = (size_t)b_ * SEQ + (size_t)n_ * 64 + i0; \
        _Pragma("unroll") for (int q = 0; q < 2; ++q) { const size_t rr_ = grow_ + 8 * q + (lane >> 3); const int cc_ = h_ * 64 + (lane & 7) * 8; \
            tlg[q] = __builtin_nontemporal_load((const u32x4*)(PROJ + proj_off(rr_, PC_GL + cc_))); tq[q] = __builtin_nontemporal_load((const u32x4*)(PROJ + proj_off(rr_, PC_GQ + cc_))); tk[q] = __builtin_nontemporal_load((const u32x4*)(PROJ + proj_off(rr_, PC_GK + cc_))); } \
        _Pragma("unroll") for (int q = 0; q < 4; ++q) tvv[q] = __builtin_nontemporal_load((const u32x4*)(PROJ + proj_off(grow_ + 4 * q + (lane >> 4), PC_GV + h_ * 128 + (lane & 15) * 8))); } while (0)
    { const int it0 = r_ * 2 + grp; if (it0 < icount) G3_LOAD_A(ibase + it0); }
    for (int rnd = 0; rnd * nl * 2 < icount; ++rnd) {
        const int li = (rnd * nl + r_) * 2 + grp, item = ibase + li; const bool valid = li < icount;
        const int nli = ((rnd + 1) * nl + r_) * 2 + grp, nitem = ibase + nli; const bool nvalid = nli < icount;
        const int h = item & 3, n = (item >> 2) & 127, b = item >> 9;
        const size_t row0 = (size_t)b * SEQ + (size_t)n * 64;
        float la[16];
        if (valid) {
            { const bf16_t* sp_ = (const bf16_t*)SIN + (size_t)item * 8192 + (32 * w4 + (lane >> 3)) * 64 + 8 * (lane & 7);
#pragma unroll
              for (int k = 0; k < 4; ++k) sv[k] = __builtin_nontemporal_load((const u32x4*)(sp_ + k * 512)); }
#pragma unroll
            for (int q = 0; q < 4; ++q) ggq[q] = __builtin_nontemporal_load((const u32x4*)(PROJ + proj_off(row0 + i0 + 4 * q + (lane >> 4), PC_GG + h * 128 + (lane & 15) * 8)));
#pragma unroll
            for (int q = 0; q < 2; ++q) { const int ro = (i0 + 8 * q + (lane >> 3)) * 144 + (lane & 7) * 16;
                *(LAS u32x4*)(gl + G3_SS + ro) = tlg[q]; *(LAS u32x4*)(gl + G3_QT + ro) = tq[q]; *(LAS u32x4*)(gl + G3_KT + ro) = tk[q]; }
#pragma unroll
            for (int q = 0; q < 4; ++q) *(LAS u32x4*)(gl + G3_VT + (i0 + 4 * q + (lane >> 4)) * 272 + (lane & 15) * 16) = tvv[q];
            LDS_FENCE();
            float run = 0.f;
#pragma unroll
            for (int i = 0; i < 16; ++i) { run += logsigmoid_f(bf2f(*(const LAS unsigned short*)(gl + G3_SS + (i0 + i) * 144 + lane * 2))) * (1.f / 16.f); la[i] = run; }
            SEG[w4 * 64 + lane] = run;
        }
        LBAR();
        if (valid) {
            float pre = 0.f;
#pragma unroll
            for (int w = 0; w < 3; ++w) if (w < w4) pre += SEG[w * 64 + lane];
#pragma unroll
            for (int i = 0; i < 16; ++i) { const float bi = pre + la[i];
                LAS unsigned short* qp = (LAS unsigned short*)(gl + G3_QT + (i0 + i) * 144 + lane * 2); LAS unsigned short* kp = (LAS unsigned short*)(gl + G3_KT + (i0 + i) * 144 + lane * 2);
                const float qv = bf2f(*qp), kv = bf2f(*kp);
                *qp = f2bf1(qv * 0.125f * fexp(bi)); *kp = f2bf1(kv * fexp(-bi)); }
#pragma unroll
            for (int k = 0; k < 4; ++k) *(LAS u32x4*)(gl + G3_ST + (32 * w4 + 8 * k + (lane >> 3)) * 144 + (lane & 7) * 16) = sv[k];
        }
        if (nvalid) G3_LOAD_A(nitem);
        LBAR();
        if (valid) {
            const int jt = w4 >> 1, it = w4 & 1;
            f32x16 acc;
#pragma unroll
            for (int q = 0; q < 16; ++q) acc[q] = 0.f;
            if (!(jt == 1 && it == 0)) {
#pragma unroll
                for (int s = 0; s < 4; ++s) { const bf16x8 a = *(const LAS bf16x8*)(gl + G3_KT + (32 * jt + r) * 144 + (16 * s + 8 * hi) * 2); const bf16x8 bq = *(const LAS bf16x8*)(gl + G3_QT + (32 * it + r) * 144 + (16 * s + 8 * hi) * 2);
                    acc = MFMA32(a, bq, acc); } }
    #pragma unroll
            for (int g = 0; g < 4; ++g) { float v[4];
#pragma unroll
                for (int k = 0; k < 4; ++k) { const int j = 32 * jt + 8 * g + 4 * hi + k, i = 32 * it + r; v[k] = (j <= i) ? acc[4 * g + k] : 0.f; }
                u32x2 w; w.x = cvtpk(v[0], v[1]); w.y = cvtpk(v[2], v[3]);
                *(LAS u32x2*)(gl + G3_SS + (32 * it + r) * 144 + (32 * jt + 8 * g + 4 * hi) * 2) = w; }
        }
        LBAR();
        f32x16 oacc[2];
        if (valid) {
#pragma unroll
            for (int it = 0; it < 2; ++it) {
#pragma unroll
                for (int q = 0; q < 16; ++q) oacc[it][q] = 0.f;
#pragma unroll
                for (int s = 0; s < 4; ++s) { if (it == 0 && s >= 2) continue;
                    const LAS unsigned char* vr = gl + G3_VT + (16 * s + 8 * hi + ((lane & 15) >> 2)) * 272 + (32 * w4 + 16 * ((lane >> 4) & 1) + 4 * (lane & 3)) * 2;
                    const u32x2 lo = lds_tr16(vr), h2 = lds_tr16(vr + 4 * 272); const bf16x8 a = __builtin_bit_cast(bf16x8, (u32x4){lo.x, lo.y, h2.x, h2.y});
                    const bf16x8 bs = *(const LAS bf16x8*)(gl + G3_SS + (32 * it + r) * 144 + (16 * s + 8 * hi) * 2);
                    oacc[it] = MFMA32(a, bs, oacc[it]); }
#pragma unroll
                for (int s = 0; s < 4; ++s) { const bf16x8 a = *(const LAS bf16x8*)(gl + G3_ST + (32 * w4 + r) * 144 + (16 * s + 8 * hi) * 2); const bf16x8 bq = *(const LAS bf16x8*)(gl + G3_QT + (32 * it + r) * 144 + (16 * s + 8 * hi) * 2);
                    oacc[it] = MFMA32(a, bq, oacc[it]); }
                float ss = 0.f;
#pragma unroll
                for (int q = 0; q < 16; ++q) ss += oacc[it][q] * oacc[it][q];
                ss += __shfl_xor(ss, 32);
                if (hi == 0) PART[w4 * 64 + 32 * it + r] = ss;
            }
        }
        LBAR();
        if (valid) {
#pragma unroll
            for (int it = 0; it < 2; ++it) { const int i = 32 * it + r;
                const float tot = (PART[i] + PART[64 + i]) + (PART[128 + i] + PART[192 + i]); const float rstd = rsqrtf(tot * (1.f / 128.f) + EPS);
#pragma unroll
                for (int g = 0; g < 4; ++g) { const int e0 = 32 * w4 + 8 * g + 4 * hi;
                    const float y0 = oacc[it][4 * g + 0] * rstd * gw4[g][0], y1 = oacc[it][4 * g + 1] * rstd * gw4[g][1];
                    const float y2 = oacc[it][4 * g + 2] * rstd * gw4[g][2], y3 = oacc[it][4 * g + 3] * rstd * gw4[g][3];
                    u32x2 w; w.x = cvtpk(y0, y1); w.y = cvtpk(y2, y3); *(LAS u32x2*)(gl + G3_ST + i * 272 + e0 * 2) = w; } }
        }
        LBAR();
        if (valid) {
#pragma unroll
            for (int q = 0; q < 4; ++q) { const int row = i0 + 4 * q + (lane >> 4), ch = lane & 15; const u32x4 w = *(const LAS u32x4*)(gl + G3_ST + row * 272 + ch * 16); const u32x4 gg = ggq[q]; u32x4 o;
#pragma unroll
                for (int e = 0; e < 4; ++e) o[e] = cvtpk(bflo(w[e]) * silu_f(bflo(gg[e])), bfhi(w[e]) * silu_f(bfhi(gg[e])));
                *(u32x4*)(MIX + (row0 + row) * DM + h * 128 + ch * 8) = o; }
        }
    }
#undef G3_LOAD_A
    __syncthreads();
}
constexpr int SW_KS = 0, SW_VT = 36864, SW_BIAS = 73728, SW_OST = 75776;

DI void swa_item(int item, const bf16_t* PROJ, const float* rel_bias, const float* sinks, bf16_t* MIX, LAS unsigned char* lds, int tid, int wave, int lane) {
    const int kvh = item & 1, blk = (item >> 1) & 63, b = item >> 7, r = lane & 31, hi = lane >> 5;
    const size_t prow0 = (size_t)b * SEQ;
    LAS float* BIAS = (LAS float*)(lds + SW_BIAS);
    for (int c = tid; c < 2048; c += NTHR) { const int kj = c >> 3, ch = c & 7, trow = (blk - 1) * 128 + kj; u32x4 w = (u32x4){0u, 0u, 0u, 0u};
        if (trow >= 0) w = __builtin_nontemporal_load((const u32x4*)(PROJ + proj_off(prow0 + trow, PC_SK + kvh * 64 + ch * 8)));
        *(LAS u32x4*)(lds + SW_KS + kj * 144 + ch * 16) = w; }
    for (int c = tid; c < 2048; c += NTHR) { const int kj = c >> 3, ch = c & 7, trow = (blk - 1) * 128 + kj; u32x4 w = (u32x4){0u, 0u, 0u, 0u};
        if (trow >= 0) w = __builtin_nontemporal_load((const u32x4*)(PROJ + proj_off(prow0 + trow, PC_SV + kvh * 64 + ch * 8)));
        *(LAS u32x4*)(lds + SW_VT + kj * 144 + ch * 16) = w; }
    { const int g = tid >> 7, dist = tid & 127; BIAS[tid] = rel_bias[T5B[dist] * 8 + kvh * 4 + g]; }
    __syncthreads();
#pragma unroll 1
    for (int uu = 0; uu < 2; ++uu) {
        const int u = 2 * wave + uu, g = u >> 2, qt = u & 3, head = kvh * 4 + g;
        const size_t qrow = (size_t)b * SEQ + blk * 128 + 32 * qt + r;
        bf16x8 qf[4];
        { LAS unsigned char* qg = lds + SW_OST + wave * 4608; u32x4 tq[4];
#pragma unroll
          for (int q4 = 0; q4 < 4; ++q4) tq[q4] = __builtin_nontemporal_load((const u32x4*)(PROJ + proj_off((size_t)b * SEQ + blk * 128 + 32 * qt + 8 * q4 + (lane >> 3), PC_SQ + head * 64 + (lane & 7) * 8)));
#pragma unroll
          for (int q4 = 0; q4 < 4; ++q4) *(LAS u32x4*)(qg + (8 * q4 + (lane >> 3)) * 144 + (lane & 7) * 16) = tq[q4];
          LDS_FENCE();
#pragma unroll
          for (int s = 0; s < 4; ++s) qf[s] = *(const LAS bf16x8*)(qg + r * 144 + (16 * s + 8 * hi) * 2);
          LDS_FENCE(); }
        f32x16 S[5];
#pragma unroll
        for (int t = 0; t < 5; ++t) {
#pragma unroll
            for (int q = 0; q < 16; ++q) S[t][q] = 0.f;
#pragma unroll
            for (int s = 0; s < 4; ++s) { const bf16x8 a = *(const LAS bf16x8*)(lds + SW_KS + (32 * (qt + t) + r) * 144 + (16 * s + 8 * hi) * 2); S[t] = MFMA32(a, qf[s], S[t]); } }
        const float sink = sinks[head]; float m = sink;
#pragma unroll
        for (int t = 0; t < 5; ++t)
#pragma unroll
            for (int q = 0; q < 16; ++q) { const int kr = crow(q, hi), dist = 128 + r - kr - 32 * t; const bool ok = (dist >= 0) && (dist < 128) && (blk > 0 || 32 * (qt + t) + kr >= 128);
                const float sv = ok ? S[t][q] * 0.125f + BIAS[g * 128 + (dist & 127)] : -1e30f; S[t][q] = sv; m = fmaxf(m, sv); }
        m = fmaxf(m, __shfl_xor(m, 32));
        float l = 0.f;
#pragma unroll
        for (int t = 0; t < 5; ++t)
#pragma unroll
            for (int q = 0; q < 16; ++q) { const float p = fexp(S[t][q] - m); S[t][q] = p; l += p; }
        l += __shfl_xor(l, 32); l += fexp(sink - m);
        f32x16 O[2];
#pragma unroll
        for (int dt = 0; dt < 2; ++dt)
#pragma unroll
            for (int q = 0; q < 16; ++q) O[dt][q] = 0.f;
#pragma unroll
        for (int t = 0; t < 5; ++t)
#pragma unroll
            for (int s2 = 0; s2 < 2; ++s2) { u32x4 pw;
#pragma unroll
                for (int jj = 0; jj < 4; ++jj) pw[jj] = cvtpk(S[t][8 * s2 + 2 * jj], S[t][8 * s2 + 2 * jj + 1]);
                const bf16x8 pf = __builtin_bit_cast(bf16x8, pw);
#pragma unroll
                for (int dt = 0; dt < 2; ++dt) {
                    const LAS unsigned char* vr = lds + SW_VT + (32 * (qt + t) + 16 * s2 + 4 * hi + ((lane & 15) >> 2)) * 144 + (32 * dt + 16 * ((lane >> 4) & 1) + 4 * (lane & 3)) * 2;
                    const u32x2 lo = lds_tr16(vr), h2 = lds_tr16(vr + 8 * 144); const u32x4 av = (u32x4){lo.x, lo.y, h2.x, h2.y};
                    O[dt] = MFMA32(__builtin_bit_cast(bf16x8, av), pf, O[dt]); } }
        const float rl = 1.f / l;
        LAS unsigned char* og = lds + SW_OST + wave * 4608;
#pragma unroll
        for (int dt = 0; dt < 2; ++dt)
#pragma unroll
            for (int g4 = 0; g4 < 4; ++g4) { u32x2 w; w.x = cvtpk(O[dt][4 * g4] * rl, O[dt][4 * g4 + 1] * rl); w.y = cvtpk(O[dt][4 * g4 + 2] * rl, O[dt][4 * g4 + 3] * rl);
                *(LAS u32x2*)(og + r * 144 + (32 * dt + 8 * g4 + 4 * hi) * 2) = w; }
        LDS_FENCE();
#pragma unroll
        for (int q4 = 0; q4 < 4; ++q4) { const int row = 8 * q4 + (lane >> 3), ch = lane & 7; const u32x4 w = *(const LAS u32x4*)(og + row * 144 + ch * 16);
            *(u32x4*)(MIX + ((size_t)b * SEQ + blk * 128 + 32 * qt + row) * DM + 512 + head * 64 + ch * 8) = w; }
        LDS_FENCE();
    }
    __syncthreads();
}

DI void stagger_start(int bx, int ticks) {
    const int q = ((bx >> 3) & 7) >> 1;
    if (q) { const unsigned long long t0 = __builtin_amdgcn_s_memrealtime(); while (__builtin_amdgcn_s_memrealtime() - t0 < (unsigned long long)(q * ticks)) __builtin_amdgcn_s_sleep(8); }
}
struct Args { const float* in[17]; float* out; unsigned char* ws; int ph_lo, ph_hi, use_bar, pad; };
enum { I_X = 0, I_C, I_NORMW, I_ADAW, I_ADAB, I_WIN, I_WGATE, I_BGATE, I_GNW, I_SINKS, I_WOUT, I_RELB, I_POOLW, I_POOLS, I_W1, I_W2, I_FNW };
constexpr int NPHASE = 16;
constexpr int STAG1 = 450;
__device__ const int REPS[16] = {1, 1, 1, 1, 1, 1, 1, 1, 1, 1, 1, 1, 1, 1, 1, 1};

__global__ void __launch_bounds__(NTHR, 2) mk_fwd(Args args) {
    extern __shared__ __attribute__((aligned(16))) unsigned char lds_raw[];
    LAS unsigned char* lds = (LAS unsigned char*)lds_raw;
    volatile LAS unsigned* MISC = (volatile LAS unsigned*)(lds + MISC_OFF);
    const int wave = __builtin_amdgcn_readfirstlane((int)threadIdx.x >> 6);
    const int G = gridDim.x, bx = blockIdx.x;
    const int vcu = (G % 8 == 0) ? (bx % 8) * (G / 8) + bx / 8 : bx;
    const int gw = vcu * NWAVES + wave, NGW = G * NWAVES;
    unsigned char* ws = args.ws;
    unsigned* ctl = (unsigned*)(ws + WS_CTL);
    float* MOD = (float*)(ws + WS_MOD);
    bf16_t* WIN_T = (bf16_t*)(ws + WS_WIN); bf16_t* WOUT_T = (bf16_t*)(ws + WS_WOUT); bf16_t* W1_T = (bf16_t*)(ws + WS_W1); bf16_t* W2_T = (bf16_t*)(ws + WS_W2); bf16_t* WP_T = (bf16_t*)(ws + WS_WP);
    bf16_t* H = (bf16_t*)(ws + WS_H); bf16_t* PROJ = (bf16_t*)(ws + WS_PROJ); bf16_t* MIX = (bf16_t*)(ws + WS_MIX); bf16_t* HID = (bf16_t*)(ws + WS_HID); bf16_t* POOL = (bf16_t*)(ws + WS_POOL); bf16_t* X2B = POOL; bf16_t* WPF = (bf16_t*)(ws + WS_WPF);
    float* DS = (float*)(ws + WS_DS); float* DEC = (float*)(ws + WS_DEC); float* BIAS = (float*)(ctl + CW_BIAS); float* RS = (float*)(ctl + CW_RS); bf16_t* X1B = (bf16_t*)(ws + WS_X1B); bf16_t* WINF = (bf16_t*)(ws + WS_WINF); bf16_t* W1F0 = (bf16_t*)(ws + WS_W1F0); bf16_t* W1F1 = (bf16_t*)(ws + WS_W1F1);
    const float* x = args.in[I_X];

    if (wave == 0) MISC[lane_id()] = 0u;
    __syncthreads();
    XcdBarrier bar; bar.bar = ctl + CW_BAR; bar.x = 0; bar.st = nullptr; bar.wave = wave;
    if (args.use_bar) bar = xcd_barrier_post(ctl + CW_BAR, MISC + 8, wave);
    const int lo = args.ph_lo, hi = args.ph_hi;
#define IN(k) (lo <= (k) && (k) < hi)
#define SEAM(k) do { if (IN(k) && (k) + 1 < hi) xcd_barrier(bar); } while (0)
#define RL(k) _Pragma("unroll 1") for (int rep = 0; rep < REPS[k]; ++rep)
    const float* ZEROS = (const float*)(ctl + CW_ZEROS);

    if (IN(0)) RL(0) {
        for (int un = bx; un < 256; un += G) p0_mod_unit(un, args.in[I_C], args.in[I_ADAW], args.in[I_ADAB], MOD, lds, fresh_tid(wave), wave, (fresh_tid(wave) & 63));
        LAS float* scr = (LAS float*)(lds + wave * 16384);
        constexpr int I_OUT = 16 * 32, I_2 = 64 * 32;
        constexpr int NITEMS = I_OUT + 2 * I_2;
        for (int it = gw; it < NITEMS; it += NGW) {
            int r = it;
            if (r < I_OUT) { const int kb = r / 32, nb = r % 32; p0_transpose_item(args.in[I_WOUT], 1024, nb * 32, WOUT_T, 1024, nb * 32, kb * 64, scr, (fresh_tid(wave) & 63)); continue; } r -= I_OUT;
            { const int l = r / I_2; r -= l * I_2; const int kb = r / 32, nb = r % 32; p0_transpose_item(args.in[I_W2] + (size_t)l * 4096 * 1024, 1024, nb * 32, W2_T + (size_t)l * 1024 * 4096, 4096, nb * 32, kb * 64, scr, (fresh_tid(wave) & 63)); }
        }
        __syncthreads();
    }
    SEAM(0);
    const int uni = args.use_bar ? __builtin_amdgcn_readfirstlane((int)MISC[11]) : 0;
    const int xr = __builtin_amdgcn_readfirstlane((int)MISC[10]), xcd = (int)bar.x;
    const int cid = uni ? xr * 8 + xcd : bx;
    const int vcu2 = uni ? xcd * 32 + xr : vcu;
    const int gw2 = vcu2 * NWAVES + wave;
#define SEAM_L(k) do { if (IN(k) && (k) + 1 < hi) xcd_barrier(bar, uni); } while (0)
    if (IN(1)) RL(1) {
        LAS float* scr = (LAS float*)(lds + wave * 16384);
        float* BIASw = rep ? (float*)(ws + WS_W1) : BIAS;
        constexpr int J_IN = 16 * 72, J_GF = 16 * 8, J_1 = 16 * 128, J_P = 4 * 32;
        for (int it = gw2; it < J_IN + J_GF + 2 * J_1 + J_P; it += NGW) {
            int r = it; const int ln = (fresh_tid(wave) & 63);
            if (r < J_IN) { const int kb = r / 72, nb = r % 72, n0 = nb * 32; p1_fold_item(args.in[I_WIN], INCOLS, n0 < 1536 ? n0 : n0 + 16, WINF, (size_t)NPROJ * 1024, 1024, n0, kb * 64, kb * 64, args.in[I_NORMW], MOD, BIASw, NPROJ, scr, ln); continue; } r -= J_IN;
            if (r < J_GF) { const int kb = r / 8, nb = r % 8; p1_gatefold_item(args.in[I_WIN], args.in[I_WGATE], args.in[I_BGATE], WINF, (size_t)NPROJ * 1024, nb * 32, kb * 64, args.in[I_NORMW], MOD, BIASw, NPROJ, scr, ln); continue; } r -= J_GF;
            if (r >= 2 * J_1) { r -= 2 * J_1; const int gi = r / 32; r -= gi * 32; const int kb = r / 8, nb = r % 8;
              p1_fold_item(args.in[I_POOLW] + (size_t)gi * 65536, 256, nb * 32, WPF, (size_t)1024 * 256, 256, 256 * gi + nb * 32, kb * 64, 256 * gi + kb * 64, args.in[I_NORMW] + 2 * 1024, MOD + (size_t)2 * 4 * 3072, nullptr, 0, scr, ln); continue; }
            { const int l = r / J_1; r -= l * J_1; const int kb = r / 128, nb = r % 128; const int ls = 2 * l + 1;
              p1_fold_item(args.in[I_W1] + (size_t)l * 1024 * 4096, 4096, nb * 32, l ? W1F1 : W1F0, (size_t)FF * 1024, 1024, nb * 32, kb * 64, kb * 64, args.in[I_NORMW] + ls * 1024, MOD + (size_t)ls * 4 * 3072, BIASw + 4 * NPROJ + (size_t)l * 4 * FF, FF, scr, ln); }
        }
        convert_rows(x, X1B, RS + 0 * MTOK, gw2, NGW, (fresh_tid(wave) & 63));
    }
    SEAM(1);
    if (IN(2)) { pg8::Gemm g{X1B, WINF, 1024, 1024, 1024, 0, (size_t)NPROJ * 1024}; pg8::StaticOrder S; S.init(MTOK, NPROJ, G, cid, REPS[2]);
        pg8::EpiBf16<0> E{PROJ, NPROJ / 64, RS + 0 * MTOK, BIAS, NPROJ}; pg8::gemm_phase<pg8::EpiBf16<0>, true, true>(lds, g, S, E, wave); }
    SEAM(2);
    if (IN(3)) {
        int swp = vcu2 & 1; asm volatile("" : "+s"(swp));
        if (swp) {
            RL(7) { for (int it = bx; it < 512; it += G) swa_item(it, PROJ, args.in[I_RELB], args.in[I_SINKS], MIX, lds, fresh_tid(wave), wave, (fresh_tid(wave) & 63)); }
            RL(3) { for (int it = gw2; it < 2048; it += NGW) gla_g1_item(it, PROJ, DS, DEC, lds + wave * 18432, (fresh_tid(wave) & 63));
                __syncthreads(); }
        } else {
            RL(3) { for (int it = gw2; it < 2048; it += NGW) gla_g1_item(it, PROJ, DS, DEC, lds + wave * 18432, (fresh_tid(wave) & 63));
                __syncthreads(); }
            RL(7) { for (int it = bx; it < 512; it += G) swa_item(it, PROJ, args.in[I_RELB], args.in[I_SINKS], MIX, lds, fresh_tid(wave), wave, (fresh_tid(wave) & 63)); }
        }
    }
    SEAM(3);
    if (IN(4)) RL(4) gla_scan(DS, rep + 1 < REPS[4] ? args.out : DS, DEC, bx, G, fresh_tid(wave));
    SEAM(4);
    if (IN(5)) RL(5) gla_g3_phase(PROJ, DS, args.in[I_GNW], MIX, lds, uni ? 256 * xcd : 0, uni ? xr : bx, uni ? 32 : G, uni ? 256 : 2048, wave, (fresh_tid(wave) & 63));
    SEAM_L(5);
    if (IN(6)) { pg8::Gemm g{MIX, WOUT_T, 1024, 1024, 1024, 0}; pg8::StaticOrder S; S.init(MTOK, DM, G, cid, REPS[6]);
        pg8::EpiRes<false, false> E{X1B, X1B, nullptr, MOD + 0 * 4 * 3072, nullptr, nullptr, nullptr, RS + 1 * MTOK, ZEROS}; pg8::gemm_phase<pg8::EpiRes<false, false>, true, true>(lds, g, S, E, wave); }
    SEAM(6);
    if (IN(8)) { pg8::Gemm g{X1B, W1F0, 1024, 1024, 1024, 0, (size_t)FF * 1024}; pg8::StaticOrder S; S.init(MTOK, FF, G, cid, REPS[8]);
        pg8::EpiBf16<2> E{HID, FF / 64, RS + 1 * MTOK, BIAS + 4 * 2560, FF}; pg8::gemm_phase<pg8::EpiBf16<2>, true, true>(lds, g, S, E, wave); }
    SEAM_L(8);
    if (IN(9)) { pg8::Gemm g{HID, W2_T, 64, 4096, 4096, 0, 0, (size_t)256 * 64 * 2, (size_t)(FF / 64) * 256 * 64 * 2}; pg8::StaticOrder S; S.init(MTOK, DM, G, cid, REPS[9]);
        pg8::EpiRes<false, false> E{X1B, X1B, nullptr, MOD + 1 * 4 * 3072, nullptr, nullptr, nullptr, RS + 2 * MTOK, ZEROS}; pg8::gemm_phase<pg8::EpiRes<false, false>, true, true>(lds, g, S, E, wave); }
    SEAM(9);
    if (IN(10) || IN(11)) { pg8::StaticOrder Sp; Sp.init(MTOK, DM, G, cid, 1);
        if (IN(10)) RL(10) pool_prelude(Sp, X1B, RS + 2 * MTOK, POOL, lds, fresh_tid(wave), wave); }
    if (IN(11)) { pg8::Gemm g{POOL, WPF, 1024, 256, 256, 256, (size_t)1024 * 256}; pg8::StaticOrder S; S.init(MTOK, DM, G, cid, REPS[11]);
        pg8::EpiRes<false, false> E{X1B, X2B, nullptr, MOD + 2 * 4 * 3072, args.in[I_POOLS], nullptr, nullptr, RS + 3 * MTOK, ZEROS}; pg8::gemm_phase<pg8::EpiRes<false, false>, true, true>(lds, g, S, E, wave); }
    SEAM_L(11);
    if (IN(13)) { pg8::Gemm g{X2B, W1F1, 1024, 1024, 1024, 0, (size_t)FF * 1024}; pg8::StaticOrder S; S.init(MTOK, FF, G, cid, REPS[13]);
        pg8::EpiBf16<2> E{HID, FF / 64, RS + 3 * MTOK, BIAS + 4 * 2560 + 4 * 4096, FF}; pg8::gemm_phase<pg8::EpiBf16<2>, true, true>(lds, g, S, E, wave); }
    SEAM_L(13);
    if (IN(14)) { pg8::Gemm g{HID, W2_T + (size_t)1024 * 4096, 64, 4096, 4096, 0, 0, (size_t)256 * 64 * 2, (size_t)(FF / 64) * 256 * 64 * 2}; pg8::StaticOrder S; S.init(MTOK, DM, G, cid, REPS[14]);
        pg8::EpiRes<false, false> E{X2B, X2B, nullptr, MOD + 3 * 4 * 3072, nullptr, nullptr, nullptr, nullptr, ZEROS}; pg8::gemm_phase<pg8::EpiRes<false, false>, true, true>(lds, g, S, E, wave); }
    SEAM_L(14);
    if (IN(15)) RL(15) final_norm_rows(X2B, RS + 4 * MTOK, args.out, args.in[I_FNW], uni ? 4096 * xcd + xr * NWAVES + wave : gw2, uni ? 4096 * xcd + 4096 : MTOK, uni ? 256 : NGW, (fresh_tid(wave) & 63));
#undef IN
#undef SEAM
#undef SEAM_L
#undef RL
}

#ifndef MK_N_LAUNCHES
#define MK_N_LAUNCHES 1
#endif
extern "C" void kernel_launch(void* const* d_in, const int* in_sizes, int n_in, void* d_out, int out_size, void* d_ws, size_t ws_size, hipStream_t stream) {
    static int grid = 0;
    if (grid == 0) {
        if (n_in != 17 || in_sizes[0] != MTOK * DM || out_size != MTOK * DM || ws_size < WS_END) { fprintf(stderr, "kernel_launch: unexpected shapes (n_in %d, in0 %d, out %d, ws %zu)\n", n_in, n_in > 0 ? in_sizes[0] : -1, out_size, ws_size); grid = -1; return; }
        int dev = 0, cus = 0, per_cu = 0;
        if (hipGetDevice(&dev) != hipSuccess || hipDeviceGetAttribute(&cus, hipDeviceAttributeMultiprocessorCount, dev) != hipSuccess) { grid = -1; return; }
        if (hipFuncSetAttribute((const void*)mk_fwd, hipFuncAttributeMaxDynamicSharedMemorySize, LDS_BYTES) != hipSuccess) { fprintf(stderr, "kernel_launch: hipFuncSetAttribute failed\n"); grid = -1; return; }
        if (hipOccupancyMaxActiveBlocksPerMultiprocessor(&per_cu, (const void*)mk_fwd, NTHR, LDS_BYTES) != hipSuccess || per_cu < 1) { fprintf(stderr, "kernel_launch: occupancy query says %d\n", per_cu); per_cu = 1; }
        (void)hipGetLastError();
        grid = cus;
    }
    if (grid < 0) return;
    (void)hipMemsetAsync((char*)d_ws + WS_CTL, 0, CTL_ZERO_BYTES, stream);
    Args a{};
    for (int i = 0; i < 17; ++i) a.in[i] = (const float*)d_in[i];
    a.out = (float*)d_out; a.ws = (unsigned char*)d_ws;
#if MK_N_LAUNCHES == 1
    a.ph_lo = 0; a.ph_hi = NPHASE; a.use_bar = 1;
    void* kargs[] = {&a};
    hipError_t e = hipLaunchCooperativeKernel((const void*)mk_fwd, dim3(grid), dim3(NTHR), kargs, LDS_BYTES, stream);
    if (e != hipSuccess) fprintf(stderr, "kernel_launch: cooperative launch failed: %s\n", hipGetErrorString(e));
#else
    for (int p = 0; p < NPHASE; ++p) { if (p == 7 || p == 12) continue; a.ph_lo = p; a.ph_hi = p + 1; a.use_bar = 0;
        hipLaunchKernelGGL(mk_fwd, dim3(grid), dim3(NTHR), LDS_BYTES, stream, a); }
#endif
}
```
